# Optimizing an MI355X kernel written in HIP

```python
import jax, jax.numpy as jnp
from jax import lax
import numpy as np

D_MODEL = 1024
BATCH = 1
SEQ = 16384
DEPTH = 1

HEAD_DIM = 64
NSA_HEADS = 8
NSA_KV_HEADS = 2
NSA_GROUP = NSA_HEADS // NSA_KV_HEADS
SB_HEADS = 8
MIX_WIDTH = (NSA_HEADS + SB_HEADS) * HEAD_DIM
ROPE_THETA = 500000.0
ROPE_DIM = HEAD_DIM // 4
CMP_LEN = 32
CMP_STRIDE = 16
CMP_HIDDEN = 256
SEL_LEN = 64
SEL_TOP = 16
SEL_BONUS = 1.0e4
WINDOW = 512
Q_BLOCK = 128
N_GROUPS = 4
EXPERTS_PER_GROUP = 4
N_EXPERTS = N_GROUPS * EXPERTS_PER_GROUP
TOP_K_IN_GROUP = 2
EXPERT_FF = 512
MOE_BLOCK = 128
EPS = 1e-6
NEG = -1e30

N_Q = NSA_HEADS * HEAD_DIM
N_KV = 3 * 2 * NSA_KV_HEADS * HEAD_DIM
N_GATE = NSA_HEADS * 3
N_SB = 3 * SB_HEADS * HEAD_DIM
IN_COLS = N_Q + N_KV + N_GATE + N_SB

kernel_name = "hymba_nsa_stickbreak_hiermoe"


def rms_norm(x, w):
    xf = x.astype(jnp.float32)
    y = xf * lax.rsqrt(jnp.mean(xf * xf, axis=-1, keepdims=True) + EPS)
    return (y * w.astype(jnp.float32)).astype(x.dtype)


def rope_partial(x, cos, sin):
    half = ROPE_DIM // 2
    xr = x[..., :ROPE_DIM].astype(jnp.float32)
    x1, x2 = xr[..., :half], xr[..., half:]
    rot = jnp.concatenate([x1 * cos - x2 * sin, x2 * cos + x1 * sin], axis=-1)
    return jnp.concatenate([rot.astype(x.dtype), x[..., ROPE_DIM:]], axis=-1)


def masked_softmax(s, m):
    s = jnp.where(m, s, NEG)
    mx = jnp.max(s, axis=-1, keepdims=True)
    e = jnp.where(m, jnp.exp(s - mx), 0.0)
    return e / jnp.maximum(jnp.sum(e, axis=-1, keepdims=True), 1e-30)


def compress(k, pe, w1, w2):
    B, T, G, dh = k.shape
    n_cmp = (T - CMP_LEN) // CMP_STRIDE + 1
    idx = jnp.arange(n_cmp)[:, None] * CMP_STRIDE + jnp.arange(CMP_LEN)[None, :]
    blocks = k[:, idx] + pe[:, None, :].astype(k.dtype)
    blocks = blocks.transpose(0, 3, 1, 2, 4).reshape(B, G, n_cmp, CMP_LEN * dh)
    return jax.nn.silu(blocks @ w1) @ w2


def gather_blocks(blocks, idx):
    return jax.vmap(jax.vmap(lambda bl, ix: bl[ix]))(blocks, idx)


def nsa_attention(q, k_cmp, v_cmp, k_sel, v_sel, k_win, v_win, gates, cmp_pe_k, cmp_pe_v,
                  cmp_k_w1, cmp_k_w2, cmp_v_w1, cmp_v_w2):
    B, T, H, dh = q.shape
    G, R = NSA_KV_HEADS, NSA_GROUP
    scale = dh ** -0.5
    kc = compress(k_cmp, cmp_pe_k, cmp_k_w1, cmp_k_w2)
    vc = compress(v_cmp, cmp_pe_v, cmp_v_w1, cmp_v_w2)
    n_cmp = kc.shape[2]
    cmp_start = jnp.arange(n_cmp) * CMP_STRIDE
    cmp_end = cmp_start + CMP_LEN - 1
    n_sel = T // SEL_LEN
    n_top = min(SEL_TOP, n_sel)
    sel_start = jnp.arange(n_sel) * SEL_LEN
    overlap = ((cmp_start[:, None] < sel_start[None, :] + SEL_LEN)
               & (cmp_start[:, None] + CMP_LEN > sel_start[None, :])).astype(jnp.float32)
    ks_blocks = k_sel.reshape(B, n_sel, SEL_LEN, G, dh).transpose(0, 3, 1, 2, 4)
    vs_blocks = v_sel.reshape(B, n_sel, SEL_LEN, G, dh).transpose(0, 3, 1, 2, 4)
    pad = ((0, 0), (WINDOW, 0), (0, 0), (0, 0))
    kw_pad = jnp.pad(k_win, pad)
    vw_pad = jnp.pad(v_win, pad)
    jsel = jnp.arange(n_sel)

    def block(b):
        q0 = b * Q_BLOCK
        t = q0 + jnp.arange(Q_BLOCK)
        qb = lax.dynamic_slice_in_dim(q, q0, Q_BLOCK, axis=1).reshape(B, Q_BLOCK, G, R, dh)
        s_c = jnp.einsum('bqgrd,bgnd->bgrqn', qb, kc).astype(jnp.float32) * scale
        p_c = masked_softmax(s_c, cmp_end[None, :] <= t[:, None])
        o_c = jnp.einsum('bgrqn,bgnd->bqgrd', p_c.astype(vc.dtype), vc)
        imp = jnp.einsum('bgrqn,nm->bgqm', p_c, overlap)
        bq = t // SEL_LEN
        forced = (jsel[None, :] == 0) | (jsel[None, :] == bq[:, None]) | (jsel[None, :] == bq[:, None] - 1)
        allowed = jsel[None, :] <= bq[:, None]
        score = jnp.where(allowed, imp + jnp.where(forced, SEL_BONUS, 0.0), NEG)
        _, sel_idx = lax.top_k(score, n_top)
        kg = gather_blocks(ks_blocks, sel_idx).reshape(B, G, Q_BLOCK, n_top * SEL_LEN, dh)
        vg = gather_blocks(vs_blocks, sel_idx).reshape(B, G, Q_BLOCK, n_top * SEL_LEN, dh)
        tok = (sel_idx[..., None] * SEL_LEN + jnp.arange(SEL_LEN)).reshape(B, G, Q_BLOCK, n_top * SEL_LEN)
        m_s = (tok <= t[None, None, :, None])[:, :, None]
        s_s = jnp.einsum('bqgrd,bgqkd->bgrqk', qb, kg).astype(jnp.float32) * scale
        p_s = masked_softmax(s_s, m_s)
        o_s = jnp.einsum('bgrqk,bgqkd->bqgrd', p_s.astype(vg.dtype), vg)
        kwb = lax.dynamic_slice_in_dim(kw_pad, q0, WINDOW + Q_BLOCK, axis=1)
        vwb = lax.dynamic_slice_in_dim(vw_pad, q0, WINDOW + Q_BLOCK, axis=1)
        kpos = q0 - WINDOW + jnp.arange(WINDOW + Q_BLOCK)
        m_w = (kpos[None, :] <= t[:, None]) & (t[:, None] - kpos[None, :] < WINDOW) & (kpos[None, :] >= 0)
        s_w = jnp.einsum('bqgrd,bkgd->bgrqk', qb, kwb).astype(jnp.float32) * scale
        p_w = masked_softmax(s_w, m_w)
        o_w = jnp.einsum('bgrqk,bkgd->bqgrd', p_w.astype(vwb.dtype), vwb)
        gb = lax.dynamic_slice_in_dim(gates, q0, Q_BLOCK, axis=1).reshape(B, Q_BLOCK, G, R, 3)
        o = gb[..., 0:1] * o_c + gb[..., 1:2] * o_s + gb[..., 2:3] * o_w
        return o.reshape(B, Q_BLOCK, H * dh)

    out = lax.map(block, jnp.arange(T // Q_BLOCK))
    return out.transpose(1, 0, 2, 3).reshape(B, T, H * dh)


def stick_breaking_attention(q, k, v):
    B, T, H, dh = q.shape
    scale = dh ** -0.5
    s_pos = jnp.arange(T)

    def block(b):
        q0 = b * Q_BLOCK
        t = q0 + jnp.arange(Q_BLOCK)
        qb = lax.dynamic_slice_in_dim(q, q0, Q_BLOCK, axis=1)
        z = jnp.einsum('bqhd,bshd->bhqs', qb, k).astype(jnp.float32) * scale
        mask = s_pos[None, :] < t[:, None]
        log_not = jnp.where(mask, jax.nn.log_sigmoid(-z), 0.0)
        after = lax.cumsum(log_not, axis=3, reverse=True) - log_not
        a = jnp.where(mask, jnp.exp(jax.nn.log_sigmoid(z) + after), 0.0)
        o = jnp.einsum('bhqs,bshd->bqhd', a.astype(v.dtype), v)
        return o.reshape(B, Q_BLOCK, H * dh)

    out = lax.map(block, jnp.arange(T // Q_BLOCK))
    return out.transpose(1, 0, 2, 3).reshape(B, T, H * dh)


def hybrid_mixer(h, positions, w_in, cmp_pe_k, cmp_pe_v, cmp_k_w1, cmp_k_w2, cmp_v_w1, cmp_v_w2,
                 nsa_out_norm_w, sb_out_norm_w, w_out):
    B, T, _ = h.shape
    proj = h @ w_in
    o1, o2, o3 = N_Q, N_Q + N_KV, N_Q + N_KV + N_GATE
    q_n = proj[..., :o1].reshape(B, T, NSA_HEADS, HEAD_DIM)
    kv = proj[..., o1:o2].reshape(B, T, 3, 2, NSA_KV_HEADS, HEAD_DIM)
    gates = jax.nn.sigmoid(proj[..., o2:o3].reshape(B, T, NSA_HEADS, 3))
    sb = proj[..., o3:].reshape(B, T, 3, SB_HEADS, HEAD_DIM)
    inv_freq = ROPE_THETA ** (-jnp.arange(0, ROPE_DIM, 2, dtype=jnp.float32) / ROPE_DIM)
    ang = positions.astype(jnp.float32)[..., None] * inv_freq
    cos, sin = jnp.cos(ang)[:, :, None, :], jnp.sin(ang)[:, :, None, :]
    q_n = rope_partial(q_n, cos, sin)
    k_sel = rope_partial(kv[:, :, 1, 0], cos, sin)
    k_win = rope_partial(kv[:, :, 2, 0], cos, sin)
    o_nsa = nsa_attention(q_n, kv[:, :, 0, 0], kv[:, :, 0, 1], k_sel, kv[:, :, 1, 1], k_win, kv[:, :, 2, 1],
                          gates, cmp_pe_k, cmp_pe_v, cmp_k_w1, cmp_k_w2, cmp_v_w1, cmp_v_w2)
    o_sb = stick_breaking_attention(sb[:, :, 0], sb[:, :, 1], sb[:, :, 2])
    o = jnp.concatenate([rms_norm(o_nsa, nsa_out_norm_w), rms_norm(o_sb, sb_out_norm_w)], axis=-1)
    return o @ w_out


def hierarchical_moe(h, rg_w, rg_b, re_w, re_b, w_gate, w_up, w_down):
    B, T, D = h.shape
    hf = h.reshape(B * T, D)
    N = B * T
    g_logits = (hf @ rg_w).astype(jnp.float32) + rg_b
    grp = jnp.argmax(g_logits, axis=-1)
    g_gate = jnp.take_along_axis(jax.nn.softmax(g_logits, axis=-1), grp[:, None], axis=1)[:, 0]
    e_logits = ((hf @ re_w).astype(jnp.float32) + re_b).reshape(N, N_GROUPS, EXPERTS_PER_GROUP)
    e_logits = jnp.take_along_axis(e_logits, grp[:, None, None], axis=1)[:, 0]
    top_val, top_loc = lax.top_k(e_logits, TOP_K_IN_GROUP)
    weight = g_gate[:, None] * jax.nn.softmax(top_val, axis=-1)
    expert = grp[:, None] * EXPERTS_PER_GROUP + top_loc
    flat_e = expert.reshape(-1)
    flat_t = jnp.repeat(jnp.arange(N, dtype=jnp.int32), TOP_K_IN_GROUP)
    flat_w = weight.reshape(-1)
    A = N * TOP_K_IN_GROUP
    order = jnp.argsort(flat_e)
    se = flat_e[order]
    counts = jnp.bincount(flat_e, length=N_EXPERTS)
    padded = ((counts + MOE_BLOCK - 1) // MOE_BLOCK) * MOE_BLOCK
    start = jnp.cumsum(counts) - counts
    pend = jnp.cumsum(padded)
    pstart = pend - padded
    dest = pstart[se] + jnp.arange(A) - start[se]
    R = (-(-A // MOE_BLOCK) + N_EXPERTS) * MOE_BLOCK
    nb = R // MOE_BLOCK
    row_tok = jnp.zeros((R,), jnp.int32).at[dest].set(flat_t[order])
    row_w = jnp.zeros((R,), jnp.float32).at[dest].set(flat_w[order])
    blk_exp = jnp.minimum(jnp.searchsorted(pend, jnp.arange(nb) * MOE_BLOCK, side='right'), N_EXPERTS - 1)

    def expert_block(args):
        toks, e = args
        xb = hf[toks]
        return (jax.nn.silu(xb @ w_gate[e]) * (xb @ w_up[e])) @ w_down[e]

    y = lax.map(expert_block, (row_tok.reshape(nb, MOE_BLOCK), blk_exp)).reshape(R, D)
    y = y * row_w[:, None].astype(y.dtype)
    out = jnp.zeros((N, D), h.dtype).at[row_tok].add(y)
    return out.reshape(B, T, D)


def setup_inputs(seed: int = 0) -> dict:
    key = jax.random.key(seed)
    ks = jax.random.split(key, 24)
    L, D = DEPTH, D_MODEL
    nrm = lambda k, shape, fan: jax.random.normal(k, shape, jnp.float32) * (fan ** -0.5)
    gain = lambda k, shape: 1.0 + 0.02 * jax.random.normal(k, shape, jnp.float32)
    return {
        "x": jax.random.normal(ks[0], (BATCH, SEQ, D), jnp.float32),
        "positions": jnp.broadcast_to(jnp.arange(SEQ, dtype=jnp.int32), (BATCH, SEQ)),
        "attn_norm_w": gain(ks[1], (L, D)),
        "w_in": nrm(ks[2], (L, D, IN_COLS), D),
        "cmp_pe_k": 0.02 * jax.random.normal(ks[3], (L, CMP_LEN, HEAD_DIM), jnp.float32),
        "cmp_pe_v": 0.02 * jax.random.normal(ks[4], (L, CMP_LEN, HEAD_DIM), jnp.float32),
        "cmp_k_w1": nrm(ks[5], (L, CMP_LEN * HEAD_DIM, CMP_HIDDEN), CMP_LEN * HEAD_DIM),
        "cmp_k_w2": nrm(ks[6], (L, CMP_HIDDEN, HEAD_DIM), CMP_HIDDEN),
        "cmp_v_w1": nrm(ks[7], (L, CMP_LEN * HEAD_DIM, CMP_HIDDEN), CMP_LEN * HEAD_DIM),
        "cmp_v_w2": nrm(ks[8], (L, CMP_HIDDEN, HEAD_DIM), CMP_HIDDEN),
        "nsa_out_norm_w": gain(ks[9], (L, NSA_HEADS * HEAD_DIM)),
        "sb_out_norm_w": gain(ks[10], (L, SB_HEADS * HEAD_DIM)),
        "w_out": nrm(ks[11], (L, MIX_WIDTH, D), MIX_WIDTH),
        "ffn_norm_w": gain(ks[12], (L, D)),
        "router_group_w": nrm(ks[13], (L, D, N_GROUPS), D),
        "router_group_b": 0.01 * jax.random.normal(ks[14], (L, N_GROUPS), jnp.float32),
        "router_expert_w": nrm(ks[15], (L, D, N_EXPERTS), D),
        "router_expert_b": 0.01 * jax.random.normal(ks[16], (L, N_EXPERTS), jnp.float32),
        "w_gate": nrm(ks[17], (L, N_EXPERTS, D, EXPERT_FF), D),
        "w_up": nrm(ks[18], (L, N_EXPERTS, D, EXPERT_FF), D),
        "w_down": nrm(ks[19], (L, N_EXPERTS, EXPERT_FF, D), EXPERT_FF),
        "final_norm_w": gain(ks[20], (D,)),
    }


def reference(x, positions, attn_norm_w, w_in, cmp_pe_k, cmp_pe_v, cmp_k_w1, cmp_k_w2, cmp_v_w1, cmp_v_w2,
              nsa_out_norm_w, sb_out_norm_w, w_out, ffn_norm_w, router_group_w, router_group_b,
              router_expert_w, router_expert_b, w_gate, w_up, w_down, final_norm_w):
    for i in range(DEPTH):
        h = rms_norm(x, attn_norm_w[i])
        x = x + hybrid_mixer(h, positions, w_in[i], cmp_pe_k[i], cmp_pe_v[i], cmp_k_w1[i], cmp_k_w2[i],
                             cmp_v_w1[i], cmp_v_w2[i], nsa_out_norm_w[i], sb_out_norm_w[i], w_out[i])
        h = rms_norm(x, ffn_norm_w[i])
        x = x + hierarchical_moe(h, router_group_w[i], router_group_b[i], router_expert_w[i],
                                 router_expert_b[i], w_gate[i], w_up[i], w_down[i])
    return rms_norm(x, final_norm_w)
```

```cpp
#include <hip/hip_runtime.h>
#include <hip/hip_cooperative_groups.h>
#include <stdint.h>
#include <math.h>
#include <stdio.h>
namespace cg = cooperative_groups;

#ifndef SINGLE
#define SINGLE 0
#endif

typedef unsigned short bf16_t;
using bf16x8 = __attribute__((ext_vector_type(8))) short;
using f32x4  = __attribute__((ext_vector_type(4))) float;
#define DI __device__ __forceinline__

constexpr int T = 16384, D = 1024;
constexpr int NP = 2944;
constexpr int NCMP = 1023;
constexpr int NTHREADS = 256;

constexpr size_t al256(size_t x) { return (x + 255) & ~(size_t)255; }
constexpr size_t OFF_WIN   = 0;
constexpr size_t OFF_WOUT  = OFF_WIN  + (size_t)NP * 1024 * 2;
constexpr size_t OFF_CW1   = OFF_WOUT + (size_t)1024 * 1024 * 2;
constexpr size_t OFF_CW2   = OFF_CW1  + (size_t)2 * 256 * 2048 * 2;
constexpr size_t OFF_CB1   = OFF_CW2  + (size_t)2 * 128 * 256 * 2;
constexpr size_t OFF_WGU   = OFF_CB1  + 2048;
constexpr size_t OFF_WD    = OFF_WGU  + (size_t)16 * 1024 * 1024 * 2;
constexpr size_t OFF_ROPE  = OFF_WD   + (size_t)16 * 1024 * 512 * 2;
constexpr size_t OFF_MISC  = OFF_ROPE + (size_t)T * 16 * 4;
constexpr size_t OFF_LIST  = OFF_MISC + 4096;
constexpr size_t OFF_KC    = OFF_LIST + (size_t)16 * T * 8;
constexpr size_t OFF_GATES = OFF_KC   + (size_t)4 * 1024 * 64 * 2;
constexpr size_t OFF_R1    = OFF_GATES + (size_t)T * 24 * 4;
constexpr size_t OFF_R2    = OFF_R1   + (size_t)T * 1024 * 2;
constexpr size_t OFF_QN    = OFF_R2;
constexpr size_t OFF_KV    = OFF_QN   + (size_t)T * 512 * 2;
constexpr size_t OFF_SB    = OFF_KV   + (size_t)12 * T * 64 * 2;
constexpr size_t OFF_HC    = OFF_SB   + (size_t)24 * T * 64 * 2;
constexpr size_t OFF_R2END = OFF_HC   + (size_t)4 * 1024 * 256 * 2;
constexpr size_t OFF_HID   = OFF_R2;
constexpr size_t OFF_R3    = OFF_R2END;
constexpr size_t WS_END    = OFF_R3   + (size_t)T * 1024 * 4;
static_assert(WS_END <= (size_t)256 * 1024 * 1024, "workspace overflow");
static_assert((size_t)34816 * 512 * 2 <= OFF_R2END - OFF_R2, "hidden overflow");

struct Params {
  const float* x; const int* positions; const float* attn_norm_w; const float* w_in;
  const float* cmp_pe_k; const float* cmp_pe_v; const float* cmp_k_w1; const float* cmp_k_w2;
  const float* cmp_v_w1; const float* cmp_v_w2; const float* nsa_out_norm_w; const float* sb_out_norm_w;
  const float* w_out; const float* ffn_norm_w; const float* rg_w; const float* rg_b;
  const float* re_w; const float* re_b; const float* w_gate; const float* w_up;
  const float* w_down; const float* final_norm_w;
  float* out; unsigned char* ws;
  float inv_freq[8];
};

DI bf16_t f2bf(float x) { uint32_t u = __float_as_uint(x); u += 0x7fffu + ((u >> 16) & 1u); return (bf16_t)(u >> 16); }
DI float bf2f(bf16_t b) { return __uint_as_float(((uint32_t)b) << 16); }
DI float bflo(uint32_t u) { return __uint_as_float(u << 16); }
DI float bfhi(uint32_t u) { return __uint_as_float(u & 0xffff0000u); }
DI float wave_max(float v) { for (int o = 32; o; o >>= 1) v = fmaxf(v, __shfl_xor(v, o)); return v; }
DI float wave_sum(float v) { for (int o = 32; o; o >>= 1) v += __shfl_xor(v, o); return v; }
DI float rdlane(float v, int i) { return __int_as_float(__builtin_amdgcn_readlane(__float_as_int(v), i)); }
DI float sigmoidf_(float x) { return 1.f / (1.f + __expf(-x)); }
DI int opaque0() { int z = 0; asm volatile("" : "+v"(z)); return z; }

template <class AP, class Epi>
DI void gemm128(AP aptr, const bf16_t* Bt, int ldb, int K, Epi epi, unsigned char* smem) {
  bf16_t* As = (bf16_t*)smem;
  bf16_t* Bs = As + 128 * 72;
  const int tid = threadIdx.x, lane = tid & 63, w = tid >> 6, wr = w >> 1, wc = w & 1;
  const int lr = tid >> 3, lch = tid & 7;
  const bf16_t* ap0 = aptr(lr) + lch * 8;
  const bf16_t* ap1 = aptr(lr + 32) + lch * 8;
  const bf16_t* ap2 = aptr(lr + 64) + lch * 8;
  const bf16_t* ap3 = aptr(lr + 96) + lch * 8;
  const bf16_t* bp0 = Bt + (size_t)(lr) * ldb + lch * 8;
  const bf16_t* bp1 = Bt + (size_t)(lr + 32) * ldb + lch * 8;
  const bf16_t* bp2 = Bt + (size_t)(lr + 64) * ldb + lch * 8;
  const bf16_t* bp3 = Bt + (size_t)(lr + 96) * ldb + lch * 8;
  uint4 ra0, ra1, ra2, ra3, rb0, rb1, rb2, rb3;
  ra0 = *(const uint4*)ap0; ra1 = *(const uint4*)ap1; ra2 = *(const uint4*)ap2; ra3 = *(const uint4*)ap3;
  rb0 = *(const uint4*)bp0; rb1 = *(const uint4*)bp1; rb2 = *(const uint4*)bp2; rb3 = *(const uint4*)bp3;
  f32x4 acc[4][4];
#pragma unroll
  for (int m = 0; m < 4; ++m)
#pragma unroll
    for (int n = 0; n < 4; ++n) acc[m][n] = (f32x4){0.f, 0.f, 0.f, 0.f};
  const int so = lr * 72 + lch * 8;
  for (int k0 = 0; k0 < K; k0 += 64) {
    if (k0) __syncthreads();
    *(uint4*)&As[so] = ra0; *(uint4*)&As[so + 32 * 72] = ra1; *(uint4*)&As[so + 64 * 72] = ra2; *(uint4*)&As[so + 96 * 72] = ra3;
    *(uint4*)&Bs[so] = rb0; *(uint4*)&Bs[so + 32 * 72] = rb1; *(uint4*)&Bs[so + 64 * 72] = rb2; *(uint4*)&Bs[so + 96 * 72] = rb3;
    __syncthreads();
    if (k0 + 64 < K) {
      const int kn = k0 + 64;
      ra0 = *(const uint4*)(ap0 + kn); ra1 = *(const uint4*)(ap1 + kn); ra2 = *(const uint4*)(ap2 + kn); ra3 = *(const uint4*)(ap3 + kn);
      rb0 = *(const uint4*)(bp0 + kn); rb1 = *(const uint4*)(bp1 + kn); rb2 = *(const uint4*)(bp2 + kn); rb3 = *(const uint4*)(bp3 + kn);
    }
#pragma unroll
    for (int kk = 0; kk < 2; ++kk) {
      bf16x8 a[4], b[4];
#pragma unroll
      for (int m = 0; m < 4; ++m) a[m] = *(const bf16x8*)&As[(wr * 64 + m * 16 + (lane & 15)) * 72 + kk * 32 + (lane >> 4) * 8];
#pragma unroll
      for (int n = 0; n < 4; ++n) b[n] = *(const bf16x8*)&Bs[(wc * 64 + n * 16 + (lane & 15)) * 72 + kk * 32 + (lane >> 4) * 8];
#pragma unroll
      for (int m = 0; m < 4; ++m)
#pragma unroll
        for (int n = 0; n < 4; ++n) acc[m][n] = __builtin_amdgcn_mfma_f32_16x16x32_bf16(a[m], b[n], acc[m][n], 0, 0, 0);
    }
  }
  epi(acc, wr, wc, lane);
  __syncthreads();
}

template <class RowMap>
DI void transpose_tile64(const float* src, int ldsrc, int k0, int nsrc0, int ncols_valid, const float* rowscale,
                         bf16_t* dst, int lddst, RowMap dstrow, float* tile  ) {
  const int tid = threadIdx.x;
  const int c = tid & 63, r4 = tid >> 6;
#pragma unroll 4
  for (int i = 0; i < 16; ++i) {
    const int k = i * 4 + r4;
    float v = 0.f;
    if (c < ncols_valid) v = src[(size_t)(k0 + k) * ldsrc + nsrc0 + c];
    if (rowscale) v *= rowscale[k0 + k];
    tile[k * 65 + c] = v;
  }
  __syncthreads();
#pragma unroll 4
  for (int i = 0; i < 16; ++i) {
    const int n = i * 4 + r4;
    dst[(size_t)dstrow(n) * lddst + k0 + c] = f2bf(tile[c * 65 + n]);
  }
  __syncthreads();
}

constexpr int J_WIN = 16 * 46, J_WOUT = 16 * 16, J_CW1 = 2 * 32 * 4, J_CW2 = 2 * 4, J_WG = 16 * 16 * 8, J_WU = J_WG, J_WDN = 16 * 8 * 16;
constexpr int J_XB = T / 4, J_ROPE = T * 8 / 256, J_BIAS = 2, J_ZERO = 1;
constexpr int JB_WOUT = J_WIN, JB_CW1 = JB_WOUT + J_WOUT, JB_CW2 = JB_CW1 + J_CW1, JB_WG = JB_CW2 + J_CW2, JB_WU = JB_WG + J_WG,
              JB_WDN = JB_WU + J_WU, JB_XB = JB_WDN + J_WDN, JB_ROPE = JB_XB + J_XB, JB_BIAS = JB_ROPE + J_ROPE, JB_ZERO = JB_BIAS + J_BIAS,
              J_TOTAL = JB_ZERO + J_ZERO;

DI void phase_prep(const Params& p, unsigned char* smem) {
  float* tile = (float*)smem;
  const int tid = threadIdx.x, lane = tid & 63, w = tid >> 6;
  for (int job = blockIdx.x; job < J_TOTAL; job += gridDim.x) {
    if (job < JB_WOUT) {
      const int kt = job / 46, nt = job % 46, nb = nt * 64;
      int srcc = 0, nv = 64;
      if (nb < 1280) srcc = nb; else if (nb < 2816) srcc = nb + 24; else if (nb == 2816) { srcc = 1280; nv = 24; } else nv = 0;
      transpose_tile64(p.w_in, 2840, kt * 64, srcc, nv, nullptr, (bf16_t*)(p.ws + OFF_WIN), 1024, [=](int n) { return nb + n; }, tile);
    } else if (job < JB_CW1) {
      const int j = job - JB_WOUT, kt = j / 16, nt = j % 16;
      const float* rs = (kt < 8) ? p.nsa_out_norm_w : (p.sb_out_norm_w - 512);
      transpose_tile64(p.w_out, 1024, kt * 64, nt * 64, 64, rs, (bf16_t*)(p.ws + OFF_WOUT), 1024, [=](int n) { return nt * 64 + n; }, tile);
    } else if (job < JB_CW2) {
      const int j = job - JB_CW1, kv = j / 128, kt = (j % 128) / 4, nt = j % 4;
      transpose_tile64(kv ? p.cmp_v_w1 : p.cmp_k_w1, 256, kt * 64, nt * 64, 64, nullptr, (bf16_t*)(p.ws + OFF_CW1) + (size_t)kv * 256 * 2048, 2048,
                       [=](int n) { return nt * 64 + n; }, tile);
    } else if (job < JB_WG) {
      const int j = job - JB_CW2, kv = j / 4, kt = j % 4;
      bf16_t* dst = (bf16_t*)(p.ws + OFF_CW2) + (size_t)kv * 128 * 256;
      transpose_tile64(kv ? p.cmp_v_w2 : p.cmp_k_w2, 64, kt * 64, 0, 64, nullptr, dst, 256, [=](int n) { return n; }, tile);
      for (int i = tid; i < 64 * 64; i += NTHREADS) dst[(size_t)(64 + i / 64) * 256 + kt * 64 + (i % 64)] = 0;
    } else if (job < JB_WDN) {
      const int up = job >= JB_WU;
      const int j = job - (up ? JB_WU : JB_WG), e = j / 128, kt = (j % 128) / 8, nt = j % 8;
      const float* src = (up ? p.w_up : p.w_gate) + (size_t)e * 1024 * 512;
      transpose_tile64(src, 512, kt * 64, nt * 64, 64, nullptr, (bf16_t*)(p.ws + OFF_WGU) + (size_t)e * 1024 * 1024, 1024,
                       [=](int n) { const int jj = nt * 64 + n; return (jj >> 4) * 32 + (jj & 15) + up * 16; }, tile);
    } else if (job < JB_XB) {
      const int j = job - JB_WDN, e = j / 128, kt = (j % 128) / 16, nt = j % 16;
      transpose_tile64(p.w_down + (size_t)e * 512 * 1024, 1024, kt * 64, nt * 64, 64, nullptr, (bf16_t*)(p.ws + OFF_WD) + (size_t)e * 1024 * 512, 512,
                       [=](int n) { return nt * 64 + n; }, tile);
    } else if (job < JB_ROPE) {
      const int row = (job - JB_XB) * 4 + w;
      const float4* xr = (const float4*)(p.x + (size_t)row * 1024);
      float4 v[4]; float ss = 0.f;
#pragma unroll
      for (int i = 0; i < 4; ++i) { v[i] = xr[lane + 64 * i]; ss += v[i].x * v[i].x + v[i].y * v[i].y + v[i].z * v[i].z + v[i].w * v[i].w; }
      ss = wave_sum(ss);
      const float rstd = rsqrtf(ss * (1.f / 1024.f) + 1e-6f);
      bf16_t* dst = (bf16_t*)(p.ws + OFF_R1) + (size_t)row * 1024;
#pragma unroll
      for (int i = 0; i < 4; ++i) {
        const float4 wv = ((const float4*)p.attn_norm_w)[lane + 64 * i];
        ushort4 o; o.x = f2bf(v[i].x * rstd * wv.x); o.y = f2bf(v[i].y * rstd * wv.y); o.z = f2bf(v[i].z * rstd * wv.z); o.w = f2bf(v[i].w * rstd * wv.w);
        *(ushort4*)(dst + (lane + 64 * i) * 4) = o;
      }
    } else if (job < JB_BIAS) {
      const int idx = (job - JB_ROPE) * 256 + tid, t = idx >> 3, i = idx & 7;
      const float ang = (float)p.positions[t] * p.inv_freq[i];
      const double rev = (double)ang * 0.15915494309189533577;
      const float fr = (float)(rev - rint(rev));
      float* rt = (float*)(p.ws + OFF_ROPE);
      rt[idx * 2] = __builtin_amdgcn_cosf(fr); rt[idx * 2 + 1] = __builtin_amdgcn_sinf(fr);
    } else if (job < JB_ZERO) {
      const int kv = job - JB_BIAS;
      const float* pe = kv ? p.cmp_pe_v : p.cmp_pe_k; const float* w1 = kv ? p.cmp_v_w1 : p.cmp_k_w1;
      float s = 0.f;
      for (int i = 0; i < 2048; ++i) s += pe[i] * w1[(size_t)i * 256 + tid];
      ((float*)(p.ws + OFF_CB1))[kv * 256 + tid] = s;
    } else {
      if (tid < 16) ((int*)(p.ws + OFF_MISC))[tid] = 0;
    }
  }
}

DI void phase_inproj(const Params& p, unsigned char* smem) {
  const bf16_t* xb = (const bf16_t*)(p.ws + OFF_R1);
  const bf16_t* WinT = (const bf16_t*)(p.ws + OFF_WIN);
  const float* rope = (const float*)(p.ws + OFF_ROPE);
  bf16_t* Qn = (bf16_t*)(p.ws + OFF_QN); bf16_t* KV = (bf16_t*)(p.ws + OFF_KV); bf16_t* SB = (bf16_t*)(p.ws + OFF_SB);
  float* gates = (float*)(p.ws + OFF_GATES);
  for (int tile = blockIdx.x; tile < 128 * 23; tile += gridDim.x) {
    const int rt = tile / 23, ct = tile % 23, row0 = rt * 128;
    auto epi = [=](f32x4 (&acc)[4][4], int wr, int wc, int lane) {
      const int quad = lane >> 4, lc = lane & 15;
#pragma unroll
      for (int m = 0; m < 4; ++m) {
#pragma unroll
        for (int n = 0; n < 4; ++n) {
          const int colb = ct * 128 + wc * 64 + n * 16;
          const int rowb = row0 + wr * 64 + m * 16 + quad * 4;
          bf16_t* dst = nullptr; int ld = 0; bool dorope = false; float scale = 1.f;
          if (colb < 512) { dst = Qn + colb + lc; ld = 512; dorope = (colb & 63) == 0; scale = 0.125f; }
          else if (colb < 1280) { const int c = colb - 512, buf = c >> 6, d0 = c & 63; dst = KV + (size_t)buf * T * 64 + d0 + lc; ld = 64;
                                  dorope = (d0 == 0) && ((buf & 2) == 0) && (buf >= 4); }
          else if (colb < 2816) { const int c = colb - 1280, ih = c >> 6, d0 = c & 63; dst = SB + (size_t)ih * T * 64 + d0 + lc; ld = 64; scale = (ih < 8) ? 0.125f : 1.f; }
          if (colb < 2816) {
#pragma unroll
            for (int r = 0; r < 4; ++r) {
              const int t = rowb + r;
              float v = acc[m][n][r];
              if (dorope) {
                const float pv = __shfl_xor(v, 8);
                const float2 cs = *(const float2*)(rope + ((size_t)t * 8 + (lc & 7)) * 2);
                v = (lc < 8) ? (v * cs.x - pv * cs.y) : (v * cs.x + pv * cs.y);
              }
              dst[(size_t)t * ld] = f2bf(v * scale);
            }
          } else if (colb < 2848) {
            const int cgi = colb - 2816 + lc;
            if (cgi < 24) {
#pragma unroll
              for (int r = 0; r < 4; ++r) gates[(size_t)(rowb + r) * 24 + cgi] = sigmoidf_(acc[m][n][r]);
            }
          }
        }
      }
    };
    gemm128([=](int r) { return xb + (size_t)(row0 + r) * 1024; }, WinT + (size_t)ct * 128 * 1024, 1024, 1024, epi, smem);
  }
}

DI void phase_cmp1(const Params& p, unsigned char* smem) {
  const bf16_t* KV = (const bf16_t*)(p.ws + OFF_KV);
  bf16_t* HC = (bf16_t*)(p.ws + OFF_HC);
  const float* cb1 = (const float*)(p.ws + OFF_CB1);
  for (int tile = blockIdx.x; tile < 64; tile += gridDim.x) {
    const int kvg = tile >> 4, kv = kvg >> 1, g = kvg & 1, rt = (tile >> 1) & 7, ct = tile & 1;
    const bf16_t* src = KV + (size_t)(kv * 2 + g) * T * 64;
    bf16_t* hc = HC + (size_t)kvg * 1024 * 256;
    auto epi = [=](f32x4 (&acc)[4][4], int wr, int wc, int lane) {
      const int quad = lane >> 4, lc = lane & 15;
#pragma unroll
      for (int m = 0; m < 4; ++m)
#pragma unroll
        for (int n = 0; n < 4; ++n) {
          const int col = ct * 128 + wc * 64 + n * 16 + lc;
          const float b = cb1[kv * 256 + col];
#pragma unroll
          for (int r = 0; r < 4; ++r) {
            const int row = rt * 128 + wr * 64 + m * 16 + quad * 4 + r;
            const float v = acc[m][n][r] + b;
            hc[(size_t)row * 256 + col] = f2bf(v * sigmoidf_(v));
          }
        }
    };
    gemm128([=](int r) { return src + (size_t)(rt * 128 + r) * 1024; }, (const bf16_t*)(p.ws + OFF_CW1) + (size_t)kv * 256 * 2048 + (size_t)ct * 128 * 2048, 2048, 2048, epi, smem);
  }
}
DI void phase_cmp2(const Params& p, unsigned char* smem) {
  const bf16_t* HC = (const bf16_t*)(p.ws + OFF_HC);
  bf16_t* KC = (bf16_t*)(p.ws + OFF_KC);
  for (int tile = blockIdx.x; tile < 32; tile += gridDim.x) {
    const int kvg = tile >> 3, kv = kvg >> 1, rt = tile & 7;
    const bf16_t* hc = HC + (size_t)kvg * 1024 * 256;
    bf16_t* kc = KC + (size_t)kvg * 1024 * 64;
    auto epi = [=](f32x4 (&acc)[4][4], int wr, int wc, int lane) {
      const int quad = lane >> 4, lc = lane & 15;
      if (wc == 0) {
#pragma unroll
        for (int m = 0; m < 4; ++m)
#pragma unroll
          for (int n = 0; n < 4; ++n)
#pragma unroll
            for (int r = 0; r < 4; ++r) {
              const int row = rt * 128 + wr * 64 + m * 16 + quad * 4 + r;
              kc[(size_t)row * 64 + n * 16 + lc] = f2bf(acc[m][n][r]);
            }
      }
    };
    gemm128([=](int r) { return hc + (size_t)(rt * 128 + r) * 256; }, (const bf16_t*)(p.ws + OFF_CW2) + (size_t)kv * 128 * 256, 256, 256, epi, smem);
  }
}

DI void dot4(const float* qs, const bf16_t* krow, float (&s)[4]) {
  s[0] = s[1] = s[2] = s[3] = 0.f;
#pragma unroll
  for (int c = 0; c < 8; ++c) {
    const uint4 u = ((const uint4*)krow)[c];
    const float f[8] = {bflo(u.x), bfhi(u.x), bflo(u.y), bfhi(u.y), bflo(u.z), bfhi(u.z), bflo(u.w), bfhi(u.w)};
#pragma unroll
    for (int e = 0; e < 8; ++e) {
#pragma unroll
      for (int r = 0; r < 4; ++r) s[r] += qs[r * 64 + c * 8 + e] * f[e];
    }
  }
}
DI float dot1(const float* qs, const bf16_t* krow) {
  float s = 0.f;
#pragma unroll
  for (int c = 0; c < 8; ++c) {
    const uint4 u = ((const uint4*)krow)[c];
    const float f[8] = {bflo(u.x), bfhi(u.x), bflo(u.y), bfhi(u.y), bflo(u.z), bfhi(u.z), bflo(u.w), bfhi(u.w)};
#pragma unroll
    for (int e = 0; e < 8; ++e) s += qs[c * 8 + e] * f[e];
  }
  return s;
}

DI void attend_chunk(const float* qs, const bf16_t* K, const bf16_t* V, int key0, int t, int lane,
                     float (&mr)[4], float (&lr)[4], float (&orr)[4]) {
  const int key = key0 + lane;
  const bool valid = key <= t;
  const int kc = key < T ? key : T - 1;
  float s[4];
  dot4(qs + opaque0(), K + (size_t)kc * 64, s);
  float pr[4];
#pragma unroll
  for (int r = 0; r < 4; ++r) {
    const float sv = valid ? s[r] : -INFINITY;
    const float cm = wave_max(sv);
    const float mn = fmaxf(mr[r], cm);
    const float alpha = __expf(mr[r] - mn);
    pr[r] = valid ? __expf(sv - mn) : 0.f;
    lr[r] = lr[r] * alpha + wave_sum(pr[r]);
    mr[r] = mn;
    orr[r] *= alpha;
  }
#pragma unroll 2
  for (int i = 0; i < 64; ++i) {
    int ki = key0 + i; ki = ki < T ? ki : T - 1;
    const float v = bf2f(V[(size_t)ki * 64 + lane]);
#pragma unroll
    for (int r = 0; r < 4; ++r) orr[r] += rdlane(pr[r], i) * v;
  }
}

constexpr int ATT_NSA_JOBS = T * 2 / 4;
constexpr int ATT_SB_JOBS  = T * 8 / 4;
DI void phase_attn(const Params& p, unsigned char* smem) {
  const int tid = threadIdx.x, lane = tid & 63, w = tid >> 6;
  float* wsm = (float*)smem + w * 2304;
  float* qs = wsm; float* sc = wsm + 256; float* ps = wsm + 1280;
  const bf16_t* Qn = (const bf16_t*)(p.ws + OFF_QN); const bf16_t* KV = (const bf16_t*)(p.ws + OFF_KV); const bf16_t* SB = (const bf16_t*)(p.ws + OFF_SB);
  const bf16_t* KC = (const bf16_t*)(p.ws + OFF_KC);
  const float* gates = (const float*)(p.ws + OFF_GATES);
  float* omix = (float*)(p.ws + OFF_R3);
  for (int job = blockIdx.x; job < ATT_NSA_JOBS + ATT_SB_JOBS; job += gridDim.x) {
    if (job < ATT_NSA_JOBS) {
      const int item = job * 4 + w, t = item >> 1, g = item & 1;
      for (int i = lane; i < 256; i += 64) qs[i] = bf2f(Qn[(size_t)t * 512 + g * 256 + i]);
      for (int i = lane; i < 1024; i += 64) ps[i] = 0.f;
      const bf16_t* kc = KC + (size_t)(0 * 2 + g) * 1024 * 64;
      const bf16_t* vc = KC + (size_t)(1 * 2 + g) * 1024 * 64;
      int nv = t >= 31 ? ((t - 31) >> 4) + 1 : 0; if (nv > NCMP) nv = NCMP;
      float oc[4];
#pragma nounroll
      for (int r = 0; r < 4; ++r) {
        float mx = -INFINITY;
#pragma nounroll
        for (int n = lane; n < nv; n += 64) { const float s = dot1(qs + r * 64 + opaque0(), kc + (size_t)n * 64); sc[n] = s; mx = fmaxf(mx, s); }
        mx = wave_max(mx);
        float sum = 0.f;
        for (int n = lane; n < nv; n += 64) { const float e = __expf(sc[n] - mx); sc[n] = e; sum += e; }
        sum = wave_sum(sum);
        const float inv = nv > 0 ? 1.f / fmaxf(sum, 1e-30f) : 0.f;
        for (int n = lane; n < nv; n += 64) { const float pr = sc[n] * inv; sc[n] = pr; ps[n] += pr; }
        float o = 0.f;
#pragma unroll 4
        for (int n = 0; n < nv; ++n) o += sc[n] * bf2f(vc[(size_t)n * 64 + lane]);
        if (r == 0) oc[0] = o; else if (r == 1) oc[1] = o; else if (r == 2) oc[2] = o; else oc[3] = o;
      }
      const int bq = t >> 6;
      float cand[4];
#pragma unroll
      for (int i = 0; i < 4; ++i) {
        const int m = lane + 64 * i;
        float imp = 0.f;
#pragma unroll
        for (int dn = -1; dn <= 3; ++dn) { const int n = 4 * m + dn; if (n >= 0 && n < NCMP) imp += ps[n]; }
        const bool allowed = m <= bq, forced = (m == 0) || (m == bq) || (m == bq - 1);
        cand[i] = allowed ? imp + (forced ? 1.0e4f : 0.f) : -1e30f;
      }
      int* selidx = (int*)sc;
      for (int k = 0; k < 16; ++k) {
        float bv = cand[0]; int bi = lane;
#pragma unroll
        for (int i = 1; i < 4; ++i) if (cand[i] > bv) { bv = cand[i]; bi = lane + 64 * i; }
        for (int o = 32; o; o >>= 1) {
          const float ov = __shfl_xor(bv, o); const int oi = __shfl_xor(bi, o);
          if (ov > bv || (ov == bv && oi < bi)) { bv = ov; bi = oi; }
        }
#pragma unroll
        for (int i = 0; i < 4; ++i) if (bi == lane + 64 * i) cand[i] = -3.0e38f;
        if (lane == 0) selidx[k] = bi;
      }
      float mr[4], lr[4], osel[4];
#pragma unroll
      for (int r = 0; r < 4; ++r) { mr[r] = -INFINITY; lr[r] = 0.f; osel[r] = 0.f; }
      {
        const bf16_t* K = KV + (size_t)(1 * 4 + 0 * 2 + g) * T * 64; const bf16_t* V = KV + (size_t)(1 * 4 + 1 * 2 + g) * T * 64;
#pragma nounroll
        for (int k = 0; k < 16; ++k) {
          const int j = __builtin_amdgcn_readfirstlane(selidx[k]);
          if (j > bq) continue;
          attend_chunk(qs, K, V, j * 64, t, lane, mr, lr, osel);
        }
#pragma unroll
        for (int r = 0; r < 4; ++r) osel[r] = osel[r] / fmaxf(lr[r], 1e-30f);
      }
      float owin[4];
#pragma unroll
      for (int r = 0; r < 4; ++r) { mr[r] = -INFINITY; lr[r] = 0.f; owin[r] = 0.f; }
      {
        const bf16_t* K = KV + (size_t)(2 * 4 + 0 * 2 + g) * T * 64; const bf16_t* V = KV + (size_t)(2 * 4 + 1 * 2 + g) * T * 64;
        const int lo = t - 511 > 0 ? t - 511 : 0;
#pragma nounroll
        for (int k0 = lo; k0 <= t; k0 += 64) attend_chunk(qs, K, V, k0, t, lane, mr, lr, owin);
#pragma unroll
        for (int r = 0; r < 4; ++r) owin[r] = owin[r] / fmaxf(lr[r], 1e-30f);
      }
#pragma unroll
      for (int r = 0; r < 4; ++r) {
        const int h = g * 4 + r;
        const float* gt = gates + (size_t)t * 24 + h * 3;
        omix[(size_t)t * 1024 + h * 64 + lane] = gt[0] * oc[r] + gt[1] * osel[r] + gt[2] * owin[r];
      }
    } else {
      const int item = (job - ATT_NSA_JOBS) * 4 + w, t = item >> 3, h = item & 7;
      const bf16_t* Q = SB + (size_t)(0 * 8 + h) * T * 64; const bf16_t* K = SB + (size_t)(1 * 8 + h) * T * 64; const bf16_t* V = SB + (size_t)(2 * 8 + h) * T * 64;
      qs[lane] = bf2f(Q[(size_t)t * 64 + lane]);
      float carry = 0.f, o = 0.f;
      for (int c0 = t - 1; c0 >= 0; c0 -= 64) {
        const int s = c0 - lane; const bool valid = s >= 0;
        const float z = dot1(qs + opaque0(), K + (size_t)(valid ? s : 0) * 64);
        const float sp = fmaxf(z, 0.f) + log1pf(__expf(-fabsf(z)));
        const float ln = valid ? -sp : 0.f;
        float incl = ln;
        for (int o2 = 1; o2 < 64; o2 <<= 1) { const float u = __shfl_up(incl, o2); if (lane >= o2) incl += u; }
        const float la = z + ln + (incl - ln) + carry;
        const float a = valid ? __expf(la) : 0.f;
        carry += rdlane(incl, 63);
#pragma unroll 4
        for (int i = 0; i < 64; ++i) { int si = c0 - i; si = si > 0 ? si : 0; o += rdlane(a, i) * bf2f(V[(size_t)si * 64 + lane]); }
        if (carry < -104.f) break;
      }
      omix[(size_t)t * 1024 + 512 + h * 64 + lane] = o;
    }
  }
}

DI void phase_mixnorm(const Params& p, unsigned char* smem) {
  const int lane = threadIdx.x & 63, w = threadIdx.x >> 6;
  const float* omix = (const float*)(p.ws + OFF_R3);
  bf16_t* ao = (bf16_t*)(p.ws + OFF_R1);
  for (int job = blockIdx.x; job < T / 4; job += gridDim.x) {
    const int row = job * 4 + w;
    const float4* r4 = (const float4*)(omix + (size_t)row * 1024);
    float4 v[4]; float s0 = 0.f, s1 = 0.f;
#pragma unroll
    for (int i = 0; i < 4; ++i) {
      v[i] = r4[lane + 64 * i];
      const float q = v[i].x * v[i].x + v[i].y * v[i].y + v[i].z * v[i].z + v[i].w * v[i].w;
      if (i < 2) s0 += q; else s1 += q;
    }
    s0 = wave_sum(s0); s1 = wave_sum(s1);
    const float r0 = rsqrtf(s0 * (1.f / 512.f) + 1e-6f), r1 = rsqrtf(s1 * (1.f / 512.f) + 1e-6f);
#pragma unroll
    for (int i = 0; i < 4; ++i) {
      const float rs = i < 2 ? r0 : r1;
      ushort4 o; o.x = f2bf(v[i].x * rs); o.y = f2bf(v[i].y * rs); o.z = f2bf(v[i].z * rs); o.w = f2bf(v[i].w * rs);
      *(ushort4*)(ao + (size_t)row * 1024 + (lane + 64 * i) * 4) = o;
    }
  }
}

DI void phase_outproj(const Params& p, unsigned char* smem) {
  const bf16_t* ao = (const bf16_t*)(p.ws + OFF_R1);
  const bf16_t* WoutT = (const bf16_t*)(p.ws + OFF_WOUT);
  for (int tile = blockIdx.x; tile < 128 * 8; tile += gridDim.x) {
    const int rt = tile >> 3, ct = tile & 7, row0 = rt * 128;
    const float* x = p.x; float* out = p.out;
    auto epi = [=](f32x4 (&acc)[4][4], int wr, int wc, int lane) {
      const int quad = lane >> 4, lc = lane & 15;
#pragma unroll
      for (int m = 0; m < 4; ++m)
#pragma unroll
        for (int n = 0; n < 4; ++n)
#pragma unroll
          for (int r = 0; r < 4; ++r) {
            const size_t idx = (size_t)(row0 + wr * 64 + m * 16 + quad * 4 + r) * 1024 + ct * 128 + wc * 64 + n * 16 + lc;
            out[idx] = x[idx] + acc[m][n][r];
          }
    };
    gemm128([=](int r) { return ao + (size_t)(row0 + r) * 1024; }, WoutT + (size_t)ct * 128 * 1024, 1024, 1024, epi, smem);
  }
}

DI void phase_route(const Params& p, unsigned char* smem) {
  const int lane = threadIdx.x & 63, w = threadIdx.x >> 6;
  bf16_t* xb2 = (bf16_t*)(p.ws + OFF_R1);
  int* cnt = (int*)(p.ws + OFF_MISC);
  int2* list = (int2*)(p.ws + OFF_LIST);
  for (int job = blockIdx.x; job < T / 4; job += gridDim.x) {
    const int t = job * 4 + w;
    const float4* r4 = (const float4*)(p.out + (size_t)t * 1024);
    float4 v[4]; float ss = 0.f;
#pragma unroll
    for (int i = 0; i < 4; ++i) { v[i] = r4[lane + 64 * i]; ss += v[i].x * v[i].x + v[i].y * v[i].y + v[i].z * v[i].z + v[i].w * v[i].w; }
    ss = wave_sum(ss);
    const float rstd = rsqrtf(ss * (1.f / 1024.f) + 1e-6f);
    float lg[4] = {0.f, 0.f, 0.f, 0.f}; float le[16];
#pragma unroll
    for (int c = 0; c < 16; ++c) le[c] = 0.f;
#pragma unroll
    for (int i = 0; i < 4; ++i) {
      const float4 wv = ((const float4*)p.ffn_norm_w)[lane + 64 * i];
      const float hv[4] = {v[i].x * rstd * wv.x, v[i].y * rstd * wv.y, v[i].z * rstd * wv.z, v[i].w * rstd * wv.w};
      ushort4 o; o.x = f2bf(hv[0]); o.y = f2bf(hv[1]); o.z = f2bf(hv[2]); o.w = f2bf(hv[3]);
      *(ushort4*)(xb2 + (size_t)t * 1024 + (lane + 64 * i) * 4) = o;
#pragma unroll
      for (int e = 0; e < 4; ++e) {
        const int k = (lane + 64 * i) * 4 + e;
        const float4 g4 = ((const float4*)p.rg_w)[k];
        lg[0] += hv[e] * g4.x; lg[1] += hv[e] * g4.y; lg[2] += hv[e] * g4.z; lg[3] += hv[e] * g4.w;
#pragma unroll
        for (int c4 = 0; c4 < 4; ++c4) {
          const float4 e4 = ((const float4*)p.re_w)[k * 4 + c4];
          le[c4 * 4 + 0] += hv[e] * e4.x; le[c4 * 4 + 1] += hv[e] * e4.y; le[c4 * 4 + 2] += hv[e] * e4.z; le[c4 * 4 + 3] += hv[e] * e4.w;
        }
      }
    }
#pragma unroll
    for (int c = 0; c < 4; ++c) lg[c] = wave_sum(lg[c]) + p.rg_b[c];
#pragma unroll
    for (int c = 0; c < 16; ++c) le[c] = wave_sum(le[c]) + p.re_b[c];
    int grp = 0; float gm = lg[0];
#pragma unroll
    for (int c = 1; c < 4; ++c) if (lg[c] > gm) { gm = lg[c]; grp = c; }
    float gs = 0.f;
#pragma unroll
    for (int c = 0; c < 4; ++c) gs += __expf(lg[c] - gm);
    const float ggate = 1.f / gs;
    float el[4];
#pragma unroll
    for (int j = 0; j < 4; ++j) el[j] = grp == 0 ? le[j] : grp == 1 ? le[4 + j] : grp == 2 ? le[8 + j] : le[12 + j];
    int i1 = 0; float v1 = el[0];
#pragma unroll
    for (int j = 1; j < 4; ++j) if (el[j] > v1) { v1 = el[j]; i1 = j; }
    int i2 = -1; float v2 = -INFINITY;
#pragma unroll
    for (int j = 0; j < 4; ++j) if (j != i1 && el[j] > v2) { v2 = el[j]; i2 = j; }
    const float e2 = __expf(v2 - v1);
    const float w1 = ggate / (1.f + e2), w2 = ggate * e2 / (1.f + e2);
    if (lane == 0) {
      const int ea = grp * 4 + i1, eb = grp * 4 + i2;
      const int pa = atomicAdd(&cnt[ea], 1); list[(size_t)ea * T + pa] = make_int2(t * 2, __float_as_int(w1));
      const int pb = atomicAdd(&cnt[eb], 1); list[(size_t)eb * T + pb] = make_int2(t * 2 + 1, __float_as_int(w2));
    }
  }
}

DI void moe_slot(const int* cnt, int slot, int& e, int& i, int& hbase) {
  int acc = 0; e = -1; i = 0; hbase = 0;
  for (int j = 0; j < 16; ++j) {
    const int nt = (cnt[j] + 127) >> 7;
    if (e < 0 && slot < acc + nt) { e = j; i = slot - acc; hbase = (acc + i) * 128; }
    acc += nt;
  }
}
DI void phase_moe1(const Params& p, unsigned char* smem) {
  const int* cnt = (const int*)(p.ws + OFF_MISC);
  const int2* list = (const int2*)(p.ws + OFF_LIST);
  const bf16_t* xb2 = (const bf16_t*)(p.ws + OFF_R1);
  bf16_t* hid = (bf16_t*)(p.ws + OFF_HID);
  for (int tile = blockIdx.x; tile < 272 * 8; tile += gridDim.x) {
    const int slot = tile >> 3, ct = tile & 7;
    int e, i, hbase; moe_slot(cnt, slot, e, i, hbase);
    if (e < 0) continue;
    const int nrow = cnt[e] - i * 128;
    const int2* le = list + (size_t)e * T + i * 128;
    auto epi = [=](f32x4 (&acc)[4][4], int wr, int wc, int lane) {
      const int quad = lane >> 4, lc = lane & 15;
#pragma unroll
      for (int m = 0; m < 4; ++m)
#pragma unroll
        for (int n2 = 0; n2 < 2; ++n2)
#pragma unroll
          for (int r = 0; r < 4; ++r) {
            const int row = wr * 64 + m * 16 + quad * 4 + r;
            const int j = ct * 64 + wc * 32 + n2 * 16 + lc;
            const float gv = acc[m][2 * n2][r], uv = acc[m][2 * n2 + 1][r];
            hid[(size_t)(hbase + row) * 512 + j] = f2bf(gv * sigmoidf_(gv) * uv);
          }
    };
    gemm128([=](int r) { const int rr = r < nrow ? r : nrow - 1; return xb2 + (size_t)(le[rr].x >> 1) * 1024; },
            (const bf16_t*)(p.ws + OFF_WGU) + (size_t)e * 1024 * 1024 + (size_t)ct * 128 * 1024, 1024, 1024, epi, smem);
  }
}
DI void phase_moe2(const Params& p, unsigned char* smem) {
  const int* cnt = (const int*)(p.ws + OFF_MISC);
  const int2* list = (const int2*)(p.ws + OFF_LIST);
  const bf16_t* hid = (const bf16_t*)(p.ws + OFF_HID);
  bf16_t* y = (bf16_t*)(p.ws + OFF_R3);
  for (int tile = blockIdx.x; tile < 272 * 8; tile += gridDim.x) {
    const int slot = tile >> 3, ct = tile & 7;
    int e, i, hbase; moe_slot(cnt, slot, e, i, hbase);
    if (e < 0) continue;
    const int nrow = cnt[e] - i * 128;
    const int2* le = list + (size_t)e * T + i * 128;
    auto epi = [=](f32x4 (&acc)[4][4], int wr, int wc, int lane) {
      const int quad = lane >> 4, lc = lane & 15;
#pragma unroll
      for (int m = 0; m < 4; ++m)
#pragma unroll
        for (int r = 0; r < 4; ++r) {
          const int row = wr * 64 + m * 16 + quad * 4 + r;
          if (row < nrow) {
            const int2 en = le[row];
            const float wgt = __int_as_float(en.y);
#pragma unroll
            for (int n = 0; n < 4; ++n) y[(size_t)en.x * 1024 + ct * 128 + wc * 64 + n * 16 + lc] = f2bf(acc[m][n][r] * wgt);
          }
        }
    };
    gemm128([=](int r) { return hid + (size_t)(hbase + r) * 512; }, (const bf16_t*)(p.ws + OFF_WD) + (size_t)e * 1024 * 512 + (size_t)ct * 128 * 512, 512, 512, epi, smem);
  }
}

DI void phase_final(const Params& p, unsigned char* smem) {
  const int lane = threadIdx.x & 63, w = threadIdx.x >> 6;
  const bf16_t* y = (const bf16_t*)(p.ws + OFF_R3);
  for (int job = blockIdx.x; job < T / 4; job += gridDim.x) {
    const int t = job * 4 + w;
    float4* r4 = (float4*)(p.out + (size_t)t * 1024);
    float4 v[4]; float ss = 0.f;
#pragma unroll
    for (int i = 0; i < 4; ++i) {
      v[i] = r4[lane + 64 * i];
      const ushort4 a = *(const ushort4*)(y + (size_t)(2 * t) * 1024 + (lane + 64 * i) * 4);
      const ushort4 b = *(const ushort4*)(y + (size_t)(2 * t + 1) * 1024 + (lane + 64 * i) * 4);
      v[i].x += bf2f(a.x) + bf2f(b.x); v[i].y += bf2f(a.y) + bf2f(b.y); v[i].z += bf2f(a.z) + bf2f(b.z); v[i].w += bf2f(a.w) + bf2f(b.w);
      ss += v[i].x * v[i].x + v[i].y * v[i].y + v[i].z * v[i].z + v[i].w * v[i].w;
    }
    ss = wave_sum(ss);
    const float rstd = rsqrtf(ss * (1.f / 1024.f) + 1e-6f);
#pragma unroll
    for (int i = 0; i < 4; ++i) {
      const float4 wv = ((const float4*)p.final_norm_w)[lane + 64 * i];
      float4 o; o.x = v[i].x * rstd * wv.x; o.y = v[i].y * rstd * wv.y; o.z = v[i].z * rstd * wv.z; o.w = v[i].w * rstd * wv.w;
      r4[lane + 64 * i] = o;
    }
  }
}

constexpr int SMEM_BYTES = 36864;
constexpr int NPHASE = 10;
template <int P> DI void run_phase(const Params& p, unsigned char* smem) {
  if (P == 0) phase_prep(p, smem);
  else if (P == 1) phase_inproj(p, smem);
  else if (P == 2) phase_cmp1(p, smem);
  else if (P == 3) phase_cmp2(p, smem);
  else if (P == 4) phase_attn(p, smem);
  else if (P == 5) phase_mixnorm(p, smem);
  else if (P == 6) phase_outproj(p, smem);
  else if (P == 7) phase_route(p, smem);
  else if (P == 8) phase_moe1(p, smem);
  else if (P == 9) phase_moe2(p, smem);
  else phase_final(p, smem);
}

template <int P> __global__ void __launch_bounds__(NTHREADS, 2) phase_kernel(Params p) {
  __shared__ __attribute__((aligned(16))) unsigned char smem[SMEM_BYTES];
  run_phase<P>(p, smem);
}

__global__ void __launch_bounds__(NTHREADS, 2) mega_kernel(Params p) {
  __shared__ __attribute__((aligned(16))) unsigned char smem[SMEM_BYTES];
  cg::grid_group grid = cg::this_grid();
  run_phase<0>(p, smem); grid.sync();
  run_phase<1>(p, smem); grid.sync();
  run_phase<2>(p, smem); grid.sync();
  run_phase<3>(p, smem); grid.sync();
  run_phase<4>(p, smem); grid.sync();
  run_phase<5>(p, smem); grid.sync();
  run_phase<6>(p, smem); grid.sync();
  run_phase<7>(p, smem); grid.sync();
  run_phase<8>(p, smem); grid.sync();
  run_phase<9>(p, smem); grid.sync();
  run_phase<10>(p, smem);
}

extern "C" void kernel_launch(void* const* d_in, const int* in_sizes, int n_in, void* d_out, int out_size, void* d_ws, size_t ws_size,
                              hipStream_t stream) {
  if (n_in != 22 || ws_size < WS_END) { fprintf(stderr, "kernel_launch: unexpected inputs (n_in %d, ws %zu < %zu)\n", n_in, ws_size, (size_t)WS_END); return; }
  Params p{};
  const float** pf = (const float**)&p;
  for (int i = 0; i < 22; ++i) pf[i] = (const float*)d_in[i];
  p.out = (float*)d_out; p.ws = (unsigned char*)d_ws;
  for (int i = 0; i < 8; ++i) p.inv_freq[i] = (float)pow(500000.0, -(double)i / 8.0);
#if SINGLE
  static int grid_blocks = 0;
  if (!grid_blocks) {
    int dev = 0, cus = 0, per_cu = 0;
    hipGetDevice(&dev);
    hipDeviceGetAttribute(&cus, hipDeviceAttributeMultiprocessorCount, dev);
    hipOccupancyMaxActiveBlocksPerMultiprocessor(&per_cu, mega_kernel, NTHREADS, 0);
    if (per_cu > 2) per_cu = 2;
    if (per_cu < 1) per_cu = 1;
    grid_blocks = cus * per_cu;
  }
  void* args[] = {&p};
  hipError_t e = hipLaunchCooperativeKernel((void*)mega_kernel, dim3(grid_blocks), dim3(NTHREADS), args, 0, stream);
  if (e != hipSuccess) fprintf(stderr, "cooperative launch failed: %s (grid %d)\n", hipGetErrorString(e), grid_blocks);
#else
  const int G = 1024;
  phase_kernel<0><<<G, NTHREADS, 0, stream>>>(p);
  phase_kernel<1><<<G, NTHREADS, 0, stream>>>(p);
  phase_kernel<2><<<G, NTHREADS, 0, stream>>>(p);
  phase_kernel<3><<<G, NTHREADS, 0, stream>>>(p);
  phase_kernel<4><<<G * 2, NTHREADS, 0, stream>>>(p);
  phase_kernel<5><<<G, NTHREADS, 0, stream>>>(p);
  phase_kernel<6><<<G, NTHREADS, 0, stream>>>(p);
  phase_kernel<7><<<G, NTHREADS, 0, stream>>>(p);
  phase_kernel<8><<<G, NTHREADS, 0, stream>>>(p);
  phase_kernel<9><<<G, NTHREADS, 0, stream>>>(p);
  phase_kernel<10><<<G, NTHREADS, 0, stream>>>(p);
#endif
}
```

```cpp
#include <hip/hip_runtime.h>
#include <hip/hip_cooperative_groups.h>
#include <stdint.h>
#include <math.h>
#include <stdio.h>
namespace cg = cooperative_groups;

#ifndef SINGLE
#define SINGLE 1
#endif

typedef unsigned short bf16_t;
using bf16x8 = __attribute__((ext_vector_type(8))) short;
using i32x8 = __attribute__((ext_vector_type(8))) int;
using f32x4  = __attribute__((ext_vector_type(4))) float;
#define DI __device__ __forceinline__

constexpr int T = 16384, D = 1024;
constexpr int NP = 2944;
constexpr int NCMP = 1023;
constexpr int NTHREADS = 256;

constexpr size_t al256(size_t x) { return (x + 255) & ~(size_t)255; }
constexpr size_t OFF_WIN   = 0;
constexpr size_t OFF_WOUT  = OFF_WIN  + (size_t)NP * 1024 * 2;
constexpr size_t OFF_WR    = OFF_WOUT + (size_t)1024 * 1024;
constexpr size_t OFF_CW1   = OFF_WOUT + (size_t)1024 * 1024 * 2;
constexpr size_t OFF_CW2   = OFF_CW1  + (size_t)2 * 256 * 2048 * 2;
constexpr size_t OFF_CB1   = OFF_CW2  + (size_t)2 * 128 * 256 * 2;
constexpr size_t OFF_WGU   = OFF_CB1  + 2 * 16 * 256 * 4;
constexpr size_t OFF_WD    = OFF_WGU  + (size_t)16 * 1024 * 1024 * 2;
constexpr size_t OFF_ROPE  = OFF_WD   + (size_t)16 * 1024 * 512 * 2;
constexpr size_t OFF_MISC  = OFF_ROPE + (size_t)T * 16 * 4;
constexpr size_t OFF_BAR   = OFF_MISC + 16384;
constexpr size_t OFF_LIST  = OFF_BAR + 16384;
constexpr size_t OFF_KC    = OFF_LIST + (size_t)16 * T * 8;
constexpr size_t OFF_GATES = OFF_KC   + (size_t)4 * 1024 * 64 * 2;
constexpr size_t OFF_RSTD2 = OFF_GATES + (size_t)T * 24 * 4;
constexpr size_t OFF_R1    = OFF_RSTD2 + (size_t)T * 4;
constexpr size_t OFF_R2    = OFF_R1   + (size_t)T * 1024 * 2;
constexpr size_t OFF_QN    = OFF_R2;
constexpr size_t OFF_KV    = OFF_QN   + (size_t)T * 512 * 2;
constexpr size_t OFF_SB    = OFF_KV   + (size_t)12 * T * 64 * 2;
constexpr size_t OFF_HC    = OFF_SB   + (size_t)24 * T * 64 * 2;
constexpr size_t OFF_R2END = OFF_HC   + (size_t)4 * 1024 * 256 * 2;
constexpr float MOE_WSC = 32.f, MOE_HSC = 8.f, MOE_YSC = 16.f;
constexpr size_t OFF_HID   = OFF_R2;
constexpr size_t OFF_X1B   = OFF_R2 + (size_t)32 * 1024 * 1024;
constexpr size_t OFF_R3    = OFF_R2END;
constexpr size_t WS_END    = OFF_R3   + (size_t)T * 1024 * 4;
static_assert(WS_END <= (size_t)256 * 1024 * 1024, "workspace overflow");
static_assert((size_t)34816 * 512 <= (size_t)32 * 1024 * 1024 && OFF_X1B + (size_t)T * 1024 * 2 <= OFF_R2END, "hidden / x1 overflow");

struct Params {
  const float* x; const int* positions; const float* attn_norm_w; const float* w_in;
  const float* cmp_pe_k; const float* cmp_pe_v; const float* cmp_k_w1; const float* cmp_k_w2;
  const float* cmp_v_w1; const float* cmp_v_w2; const float* nsa_out_norm_w; const float* sb_out_norm_w;
  const float* w_out; const float* ffn_norm_w; const float* rg_w; const float* rg_b;
  const float* re_w; const float* re_b; const float* w_gate; const float* w_up;
  const float* w_down; const float* final_norm_w;
  float* out; unsigned char* ws;
  float inv_freq[8];
};

DI bf16_t f2bf(float x) { uint32_t u = __float_as_uint(x); u += 0x7fffu + ((u >> 16) & 1u); return (bf16_t)(u >> 16); }
DI float bf2f(bf16_t b) { return __uint_as_float(((uint32_t)b) << 16); }
DI float bflo(uint32_t u) { return __uint_as_float(u << 16); }
DI float bfhi(uint32_t u) { return __uint_as_float(u & 0xffff0000u); }
DI float rdlane(float v, int i) { return __int_as_float(__builtin_amdgcn_readlane(__float_as_int(v), i)); }
DI float sigmoidf_(float x) { return 1.f / (1.f + __expf(-x)); }
DI int tidx() { int t = (int)__builtin_amdgcn_workitem_id_x(); asm volatile("" : "+v"(t)); return t; }
DI int lane_() { return tidx() & 63; }
DI float shx(float v, int m) { return __int_as_float(__builtin_amdgcn_ds_bpermute((lane_() ^ m) << 2, __float_as_int(v))); }
DI int shxi(int v, int m) { return __builtin_amdgcn_ds_bpermute((lane_() ^ m) << 2, v); }
DI float shi(float v, int src) { return __int_as_float(__builtin_amdgcn_ds_bpermute(src << 2, __float_as_int(v))); }
DI float dppx1(float v) { return __int_as_float(__builtin_amdgcn_update_dpp(0, __float_as_int(v), 0xB1, 0xF, 0xF, true)); }
DI float dppx2(float v) { return __int_as_float(__builtin_amdgcn_update_dpp(0, __float_as_int(v), 0x4E, 0xF, 0xF, true)); }
#define CNT_IDX(e) (1024 + (e) * 64)
DI int vblock() { const int G = gridDim.x, b = blockIdx.x; return (G & 7) ? b : (b & 7) * (G >> 3) + (b >> 3); }
DI float dpp_hm(float v) { return __int_as_float(__builtin_amdgcn_update_dpp(0, __float_as_int(v), 0x141, 0xF, 0xF, true)); }
DI float px32(float v) { const auto r = __builtin_amdgcn_permlane32_swap(__float_as_int(v), __float_as_int(v), false, false); return __int_as_float((lane_() & 32) ? r[0] : r[1]); }
DI float px16(float v) { const auto r = __builtin_amdgcn_permlane16_swap(__float_as_int(v), __float_as_int(v), false, false); return __int_as_float((lane_() & 16) ? r[0] : r[1]); }
DI int opaque0() { int z = 0; asm volatile("" : "+v"(z)); return z; }
DI float wave_max(float v) { for (int o = 32; o; o >>= 1) v = fmaxf(v, shx(v, o)); return v; }
DI float wave_sum(float v) { for (int o = 32; o; o >>= 1) v += shx(v, o); return v; }

#define XB_TMO      128
#define XB_XCNT(j)  (256  + 64 * (j))
#define XB_XSUB(j)  (1280 + 64 * (j))
#define XB_XGEN(j)  (2304 + 64 * (j))
#define XB_TOP      3328
#define XB_TOPGEN   3392
#define XCD_BAR_WORDS 3456
#define XB_SPIN_CAP (1u << 22)
DI unsigned xb_ld(unsigned* p)              { return __hip_atomic_load(p, __ATOMIC_RELAXED, __HIP_MEMORY_SCOPE_AGENT); }
DI unsigned xb_add(unsigned* p, unsigned v) { return __hip_atomic_fetch_add(p, v, __ATOMIC_RELAXED, __HIP_MEMORY_SCOPE_AGENT); }
DI unsigned xb_xcc_id() { return (unsigned)__builtin_amdgcn_s_getreg((3 << 11) | 20) & 0xFu; }
#define XB_SPIN(cond, bar) do { unsigned _sp = 0; while (cond) { __builtin_amdgcn_s_sleep(1); \
    if ((++_sp & 255u) == 0u) { if (xb_ld(&(bar)[XB_TMO])) break; if (_sp > XB_SPIN_CAP) { atomicAdd(&(bar)[XB_TMO], 1u); break; } } } } while (0)
struct XcdBarrier { unsigned* bar; unsigned x; volatile unsigned* st; };
DI XcdBarrier xcd_barrier_post(unsigned* bar, volatile unsigned* st) {
  XcdBarrier b; b.bar = bar; b.x = xb_xcc_id(); b.st = st;
  if (tidx() == 0) (void)xb_add(&bar[XB_XCNT(b.x)], 1u);
  return b;
}
DI void xcd_barrier_complete(unsigned* bar, unsigned x, unsigned& nloc, unsigned& nx) {
  const unsigned G = gridDim.x;
  unsigned sum, cnt, mine, sp = 0u;
  for (;;) {
    sum = 0u; cnt = 0u; mine = 0u;
#pragma unroll
    for (unsigned j = 0; j < 16; ++j) { const unsigned c = xb_ld(&bar[XB_XCNT(j)]); sum += c; cnt += (c > 0u) ? 1u : 0u; mine = (j == x) ? c : mine; }
    if (sum == G) break;
    __builtin_amdgcn_s_sleep(1);
    if ((++sp & 255u) == 0u) { if (xb_ld(&bar[XB_TMO])) break; if (sp > XB_SPIN_CAP) { atomicAdd(&bar[XB_TMO], 1u); break; } }
  }
  nloc = mine > 0u ? mine : 1u; nx = cnt > 0u ? cnt : 1u;
}
DI void xcd_barrier(const XcdBarrier& b) {
  asm volatile("s_waitcnt vmcnt(0)" ::: "memory");
  __syncthreads();
  if (tidx() == 0) {
    unsigned* bar = b.bar;
    __builtin_amdgcn_s_waitcnt(0);
    unsigned nloc = b.st[0], nx = b.st[1];
    if (nloc == 0u) { xcd_barrier_complete(bar, b.x, nloc, nx); b.st[0] = nloc; b.st[1] = nx; }
    const unsigned old = xb_add(&bar[XB_XSUB(b.x)], 1u);
    const unsigned gen = old / nloc;
    if (old + 1u == (gen + 1u) * nloc) {
      __builtin_amdgcn_fence(__ATOMIC_RELEASE, "agent");
      asm volatile("s_waitcnt vmcnt(0)" ::: "memory");
      const unsigned og = xb_add(&bar[XB_TOP], 1u);
      const unsigned tg = og / nx;
      if (og + 1u == (tg + 1u) * nx) xb_add(&bar[XB_TOPGEN], 1u);
      else XB_SPIN(xb_ld(&bar[XB_TOPGEN]) == tg, bar);
      __builtin_amdgcn_fence(__ATOMIC_ACQUIRE, "agent");
      xb_add(&bar[XB_XGEN(b.x)], 1u);
      asm volatile("s_waitcnt vmcnt(0)" ::: "memory");
    } else {
      XB_SPIN(xb_ld(&bar[XB_XGEN(b.x)]) == gen, bar);
      __builtin_amdgcn_fence(__ATOMIC_ACQUIRE, "agent");
      asm volatile("s_waitcnt vmcnt(0)" ::: "memory");
    }
  }
  __syncthreads();
}

template <class AP, class Epi>
DI void gemm128(AP aptr, const bf16_t* Bt, int ldb, int K, Epi epi, unsigned char* smem) {
  const int tid = tidx(), lane = tid & 63, w = tid >> 6, wr = w >> 1, wc = w & 1;
  const int lr = tid >> 3, lch = tid & 7;
  const int sch = (lch ^ ((lr >> 1) & 7)) * 8;
  const bf16_t* ap0 = aptr(lr) + sch;
  const bf16_t* ap1 = aptr(lr + 32) + sch;
  const bf16_t* ap2 = aptr(lr + 64) + sch;
  const bf16_t* ap3 = aptr(lr + 96) + sch;
  const bf16_t* bp0 = Bt + (size_t)(lr) * ldb + sch;
  const bf16_t* bp1 = Bt + (size_t)(lr + 32) * ldb + sch;
  const bf16_t* bp2 = Bt + (size_t)(lr + 64) * ldb + sch;
  const bf16_t* bp3 = Bt + (size_t)(lr + 96) * ldb + sch;
  unsigned char* dst0 = smem + tid * 16;
#define G_LD(P, kofs) do { P##0 = *(const uint4*)(ap0 + (kofs)); P##1 = *(const uint4*)(ap1 + (kofs)); P##2 = *(const uint4*)(ap2 + (kofs)); P##3 = *(const uint4*)(ap3 + (kofs)); \
    P##4 = *(const uint4*)(bp0 + (kofs)); P##5 = *(const uint4*)(bp1 + (kofs)); P##6 = *(const uint4*)(bp2 + (kofs)); P##7 = *(const uint4*)(bp3 + (kofs)); } while (0)
#define G_ST(P, st) do { unsigned char* d_ = dst0 + (st) * 32768; \
    *(uint4*)(d_) = P##0; *(uint4*)(d_ + 4096) = P##1; *(uint4*)(d_ + 8192) = P##2; *(uint4*)(d_ + 12288) = P##3; \
    *(uint4*)(d_ + 16384) = P##4; *(uint4*)(d_ + 20480) = P##5; *(uint4*)(d_ + 24576) = P##6; *(uint4*)(d_ + 28672) = P##7; } while (0)
#define G_BAR() asm volatile("s_waitcnt lgkmcnt(0)\n\ts_barrier" ::: "memory")
  f32x4 acc[4][4];
#pragma unroll
  for (int m = 0; m < 4; ++m)
#pragma unroll
    for (int n = 0; n < 4; ++n) acc[m][n] = (f32x4){0.f, 0.f, 0.f, 0.f};
  const int l15 = lane & 15, kq = lane >> 4, rsw = (l15 >> 1) & 7;
#define G_COMPUTE(st) do { \
    const bf16_t* As = (const bf16_t*)(smem + (st) * 32768); \
    const bf16_t* Bs = As + 128 * 64; \
    _Pragma("unroll") for (int kk = 0; kk < 2; ++kk) { \
      bf16x8 a[4], b[4]; \
      _Pragma("unroll") for (int m = 0; m < 4; ++m) a[m] = *(const bf16x8*)&As[(wr * 64 + m * 16 + l15) * 64 + (((kk * 4 + kq) ^ rsw) * 8)]; \
      _Pragma("unroll") for (int n = 0; n < 4; ++n) b[n] = *(const bf16x8*)&Bs[(wc * 64 + n * 16 + l15) * 64 + (((kk * 4 + kq) ^ rsw) * 8)]; \
      __builtin_amdgcn_s_setprio(1); \
      _Pragma("unroll") for (int m = 0; m < 4; ++m) \
        _Pragma("unroll") for (int n = 0; n < 4; ++n) acc[m][n] = __builtin_amdgcn_mfma_f32_16x16x32_bf16(a[m], b[n], acc[m][n], 0, 0, 0); \
      __builtin_amdgcn_s_setprio(0); } } while (0)
  uint4 ra0, ra1, ra2, ra3, ra4, ra5, ra6, ra7, rb0, rb1, rb2, rb3, rb4, rb5, rb6, rb7;
  G_LD(ra, 0);
  G_LD(rb, 64);
  G_ST(ra, 0);
  G_BAR();
  for (int k0 = 0; k0 < K; k0 += 128) {
    if (k0 + 128 < K) G_LD(ra, k0 + 128);
    __builtin_amdgcn_sched_barrier(0);
    G_COMPUTE(0);
    __builtin_amdgcn_sched_barrier(0);
    G_ST(rb, 1);
    G_BAR();
    if (k0 + 192 < K) G_LD(rb, k0 + 192);
    __builtin_amdgcn_sched_barrier(0);
    G_COMPUTE(1);
    __builtin_amdgcn_sched_barrier(0);
    if (k0 + 128 < K) G_ST(ra, 0);
    G_BAR();
  }
#undef G_LD
#undef G_ST
#undef G_BAR
#undef G_COMPUTE
  epi(acc, wr, wc, lane);
  __syncthreads();
}

template <class AP, class Epi>
DI void gemm128f8(AP aptr, const unsigned char* Bt, int ldb, int K, Epi epi, unsigned char* smem) {
  const int tid = tidx(), lane = tid & 63, w = tid >> 6, wr = w >> 1, wc = w & 1;
  const int lr = tid >> 3, lch = tid & 7;
  const int sch = (lch ^ ((lr >> 1) & 7)) * 16;
  const unsigned char* ap0 = aptr(lr) + sch;
  const unsigned char* ap1 = aptr(lr + 32) + sch;
  const unsigned char* ap2 = aptr(lr + 64) + sch;
  const unsigned char* ap3 = aptr(lr + 96) + sch;
  const unsigned char* bp0 = Bt + (size_t)(lr) * ldb + sch;
  const unsigned char* bp1 = Bt + (size_t)(lr + 32) * ldb + sch;
  const unsigned char* bp2 = Bt + (size_t)(lr + 64) * ldb + sch;
  const unsigned char* bp3 = Bt + (size_t)(lr + 96) * ldb + sch;
  unsigned char* dst0 = smem + tid * 16;
#define G8_LD(P, kofs) do { P##0 = *(const uint4*)(ap0 + (kofs)); P##1 = *(const uint4*)(ap1 + (kofs)); P##2 = *(const uint4*)(ap2 + (kofs)); P##3 = *(const uint4*)(ap3 + (kofs)); \
    P##4 = *(const uint4*)(bp0 + (kofs)); P##5 = *(const uint4*)(bp1 + (kofs)); P##6 = *(const uint4*)(bp2 + (kofs)); P##7 = *(const uint4*)(bp3 + (kofs)); } while (0)
#define G8_ST(P, st) do { unsigned char* d_ = dst0 + (st) * 32768; \
    *(uint4*)(d_) = P##0; *(uint4*)(d_ + 4096) = P##1; *(uint4*)(d_ + 8192) = P##2; *(uint4*)(d_ + 12288) = P##3; \
    *(uint4*)(d_ + 16384) = P##4; *(uint4*)(d_ + 20480) = P##5; *(uint4*)(d_ + 24576) = P##6; *(uint4*)(d_ + 28672) = P##7; } while (0)
#define G8_BAR() asm volatile("s_waitcnt lgkmcnt(0)\n\ts_barrier" ::: "memory")
  f32x4 acc[4][4];
#pragma unroll
  for (int m = 0; m < 4; ++m)
#pragma unroll
    for (int n = 0; n < 4; ++n) acc[m][n] = (f32x4){0.f, 0.f, 0.f, 0.f};
  const int l15 = lane & 15, kq = lane >> 4, rsw = (l15 >> 1) & 7;
  const int c0 = ((2 * kq) ^ rsw) * 16, c1 = ((2 * kq + 1) ^ rsw) * 16;
#define G8_COMPUTE(st) do { \
    const unsigned char* As = smem + (st) * 32768; \
    const unsigned char* Bs = As + 16384; \
    i32x8 a[4], b[4]; \
    _Pragma("unroll") for (int m = 0; m < 4; ++m) { \
      const unsigned char* rp = &As[(wr * 64 + m * 16 + l15) * 128]; \
      const uint4 lo = *(const uint4*)(rp + c0), hi = *(const uint4*)(rp + c1); \
      a[m] = (i32x8){(int)lo.x, (int)lo.y, (int)lo.z, (int)lo.w, (int)hi.x, (int)hi.y, (int)hi.z, (int)hi.w}; } \
    _Pragma("unroll") for (int n = 0; n < 4; ++n) { \
      const unsigned char* rp = &Bs[(wc * 64 + n * 16 + l15) * 128]; \
      const uint4 lo = *(const uint4*)(rp + c0), hi = *(const uint4*)(rp + c1); \
      b[n] = (i32x8){(int)lo.x, (int)lo.y, (int)lo.z, (int)lo.w, (int)hi.x, (int)hi.y, (int)hi.z, (int)hi.w}; } \
    __builtin_amdgcn_s_setprio(1); \
    _Pragma("unroll") for (int m = 0; m < 4; ++m) \
      _Pragma("unroll") for (int n = 0; n < 4; ++n) \
        acc[m][n] = __builtin_amdgcn_mfma_scale_f32_16x16x128_f8f6f4(a[m], b[n], acc[m][n], 0, 0, 0, 0x7F7F7F7F, 0, 0x7F7F7F7F); \
    __builtin_amdgcn_s_setprio(0); } while (0)
  uint4 ra0, ra1, ra2, ra3, ra4, ra5, ra6, ra7, rb0, rb1, rb2, rb3, rb4, rb5, rb6, rb7;
  G8_LD(ra, 0);
  G8_LD(rb, 128);
  G8_ST(ra, 0);
  G8_BAR();
  for (int k0 = 0; k0 < K; k0 += 256) {
    if (k0 + 256 < K) G8_LD(ra, k0 + 256);
    __builtin_amdgcn_sched_barrier(0);
    G8_COMPUTE(0);
    __builtin_amdgcn_sched_barrier(0);
    G8_ST(rb, 1);
    G8_BAR();
    if (k0 + 384 < K) G8_LD(rb, k0 + 384);
    __builtin_amdgcn_sched_barrier(0);
    G8_COMPUTE(1);
    __builtin_amdgcn_sched_barrier(0);
    if (k0 + 256 < K) G8_ST(ra, 0);
    G8_BAR();
  }
#undef G8_LD
#undef G8_ST
#undef G8_BAR
#undef G8_COMPUTE
  epi(acc, wr, wc, lane);
  __syncthreads();
}

template <int NK, class RowMap>
DI void transpose_tile64(const float* src, int ldsrc, int k0, int nsrc0, int ncols_valid, const float* rowscale,
                         bf16_t* dst, int lddst, RowMap dstrow, float* tile  ) {
  const int tid = tidx();
  const int c4 = (tid & 15) * 4, kb = tid >> 4;
  float4 v[NK][4];
#pragma unroll
  for (int t = 0; t < NK; ++t)
#pragma unroll
    for (int i = 0; i < 4; ++i) {
      v[t][i] = make_float4(0.f, 0.f, 0.f, 0.f);
      if (c4 < ncols_valid) v[t][i] = *(const float4*)(src + (size_t)(k0 + 64 * t + kb + 16 * i) * ldsrc + nsrc0 + c4);
    }
#pragma unroll
  for (int t = 0; t < NK; ++t) {
#pragma unroll
    for (int i = 0; i < 4; ++i) {
      const int k = kb + 16 * i;
      const float sc = rowscale ? rowscale[k0 + 64 * t + k] : 1.f;
      tile[k * 65 + c4] = v[t][i].x * sc; tile[k * 65 + c4 + 1] = v[t][i].y * sc; tile[k * 65 + c4 + 2] = v[t][i].z * sc; tile[k * 65 + c4 + 3] = v[t][i].w * sc;
    }
    __syncthreads();
    {
      const int n = tid >> 2, ks = (tid & 3) * 16;
      uint32_t pk[8];
#pragma unroll
      for (int e = 0; e < 8; ++e) pk[e] = (uint32_t)f2bf(tile[(ks + 2 * e) * 65 + n]) | ((uint32_t)f2bf(tile[(ks + 2 * e + 1) * 65 + n]) << 16);
      uint4* d = (uint4*)(dst + (size_t)dstrow(n) * lddst + k0 + 64 * t + ks);
      d[0] = make_uint4(pk[0], pk[1], pk[2], pk[3]); d[1] = make_uint4(pk[4], pk[5], pk[6], pk[7]);
    }
    __syncthreads();
  }
}

DI uint32_t pk4_fp8(float a, float b, float c, float d) {
  int v = 0;
  v = __builtin_amdgcn_cvt_pk_fp8_f32(a, b, v, false);
  v = __builtin_amdgcn_cvt_pk_fp8_f32(c, d, v, true);
  return (uint32_t)v;
}
template <int NK, class RowMap>
DI void transpose_tile64_f8(const float* src, int ldsrc, int k0, int nsrc0, float scale, const float* rowscale,
                            unsigned char* dst, int lddst, RowMap dstrow, float* tile  ) {
  const int tid = tidx();
  const int c4 = (tid & 15) * 4, kb = tid >> 4;
  float4 v[NK][4];
#pragma unroll
  for (int t = 0; t < NK; ++t)
#pragma unroll
    for (int i = 0; i < 4; ++i) v[t][i] = *(const float4*)(src + (size_t)(k0 + 64 * t + kb + 16 * i) * ldsrc + nsrc0 + c4);
#pragma unroll
  for (int t = 0; t < NK; ++t) {
#pragma unroll
    for (int i = 0; i < 4; ++i) {
      const int k = kb + 16 * i;
      const float sc = rowscale ? rowscale[k0 + 64 * t + k] * scale : scale;
      tile[k * 65 + c4] = v[t][i].x * sc; tile[k * 65 + c4 + 1] = v[t][i].y * sc; tile[k * 65 + c4 + 2] = v[t][i].z * sc; tile[k * 65 + c4 + 3] = v[t][i].w * sc;
    }
    __syncthreads();
    {
      const int n = tid >> 2, ks = (tid & 3) * 16;
      uint32_t pk[4];
#pragma unroll
      for (int e = 0; e < 4; ++e)
        pk[e] = pk4_fp8(tile[(ks + 4 * e) * 65 + n], tile[(ks + 4 * e + 1) * 65 + n], tile[(ks + 4 * e + 2) * 65 + n], tile[(ks + 4 * e + 3) * 65 + n]);
      *(uint4*)(dst + (size_t)dstrow(n) * lddst + k0 + 64 * t + ks) = make_uint4(pk[0], pk[1], pk[2], pk[3]);
    }
    __syncthreads();
  }
}

constexpr int J_WIN = 16 * 46, J_WOUT = 16 * 16, J_CW1 = 2 * 32 * 4, J_CW2 = 2 * 4, J_WG = 16 * 8 * 8, J_WU = J_WG, J_WDN = 16 * 4 * 16;
constexpr int J_XB = T / 16, J_ROPE = T * 8 / 256, J_BIAS = 32, J_ZERO = 1 + 8;
constexpr int JB_WOUT = J_WIN, JB_CW1 = JB_WOUT + J_WOUT, JB_CW2 = JB_CW1 + J_CW1, JB_WG = JB_CW2 + J_CW2, JB_WU = JB_WG + J_WG,
              JB_WDN = JB_WU + J_WU, JB_XB = JB_WDN + J_WDN, JB_ROPE = JB_XB + J_XB, JB_BIAS = JB_ROPE + J_ROPE, JB_ZERO = JB_BIAS + J_BIAS,
              J_TOTAL = JB_ZERO + J_ZERO;

DI void prep_job(const Params& p, int job, unsigned char* smem) {
  float* tile = (float*)smem;
  const int tid = tidx(), lane = tid & 63, w = tid >> 6;
  {
    if (job < JB_WOUT) {
      const int kt = job / 46, nt = job % 46, nb = nt * 64;
      int srcc = 0, nv = 64;
      if (nb < 1280) srcc = nb; else if (nb < 2816) srcc = nb + 24; else if (nb == 2816) { srcc = 1280; nv = 24; } else nv = 0;
      transpose_tile64<1>(p.w_in, 2840, kt * 64, srcc, nv, nullptr, (bf16_t*)(p.ws + OFF_WIN), 1024, [=](int n) { return nb + n; }, tile);
    } else if (job < JB_CW1) {
      const int j = job - JB_WOUT, kt = j / 16, nt = j % 16;
      const float* rs = (kt < 8) ? p.nsa_out_norm_w : (p.sb_out_norm_w - 512);
      transpose_tile64_f8<1>(p.w_out, 1024, kt * 64, nt * 64, MOE_WSC, rs, p.ws + OFF_WOUT, 1024, [=](int n) { return nt * 64 + n; }, tile);
    } else if (job < JB_CW2) {
      const int j = job - JB_CW1, kv = j / 128, kt = (j % 128) / 4, nt = j % 4;
      transpose_tile64<1>(kv ? p.cmp_v_w1 : p.cmp_k_w1, 256, kt * 64, nt * 64, 64, nullptr, (bf16_t*)(p.ws + OFF_CW1) + (size_t)kv * 256 * 2048, 2048,
                       [=](int n) { return nt * 64 + n; }, tile);
    } else if (job < JB_WG) {
      const int j = job - JB_CW2, kv = j / 4, kt = j % 4;
      bf16_t* dst = (bf16_t*)(p.ws + OFF_CW2) + (size_t)kv * 128 * 256;
      transpose_tile64<1>(kv ? p.cmp_v_w2 : p.cmp_k_w2, 64, kt * 64, 0, 64, nullptr, dst, 256, [=](int n) { return n; }, tile);
      for (int i = tid; i < 64 * 64; i += NTHREADS) dst[(size_t)(64 + i / 64) * 256 + kt * 64 + (i % 64)] = 0;
    } else if (job < JB_WDN) {
      const int up = job >= JB_WU;
      const int j = job - (up ? JB_WU : JB_WG), e = j / 64, kt = (j % 64) / 8, nt = j % 8;
      const float* src = (up ? p.w_up : p.w_gate) + (size_t)e * 1024 * 512;
      transpose_tile64_f8<2>(src, 512, kt * 128, nt * 64, MOE_WSC, nullptr, p.ws + OFF_WGU + (size_t)e * 1024 * 1024, 1024,
                       [=](int n) { const int jj = nt * 64 + n; return (jj >> 4) * 32 + (jj & 15) + up * 16; }, tile);
    } else if (job < JB_XB) {
      const int j = job - JB_WDN, e = j / 64, kt = (j % 64) / 16, nt = j % 16;
      transpose_tile64_f8<2>(p.w_down + (size_t)e * 512 * 1024, 1024, kt * 128, nt * 64, MOE_WSC, nullptr, p.ws + OFF_WD + (size_t)e * 1024 * 512, 512,
                       [=](int n) { return nt * 64 + n; }, tile);
    } else if (job < JB_ROPE) {
      const int row0 = (job - JB_XB) * 16 + w * 4;
      float4 v[4][4];
#pragma unroll
      for (int r = 0; r < 4; ++r)
#pragma unroll
        for (int i = 0; i < 4; ++i) v[r][i] = ((const float4*)(p.x + (size_t)(row0 + r) * 1024))[lane + 64 * i];
      float4 wv[4];
#pragma unroll
      for (int i = 0; i < 4; ++i) wv[i] = ((const float4*)p.attn_norm_w)[lane + 64 * i];
#pragma unroll
      for (int r = 0; r < 4; ++r) {
        float ss = 0.f;
#pragma unroll
        for (int i = 0; i < 4; ++i) ss += v[r][i].x * v[r][i].x + v[r][i].y * v[r][i].y + v[r][i].z * v[r][i].z + v[r][i].w * v[r][i].w;
        ss = wave_sum(ss);
        const float rstd = rsqrtf(ss * (1.f / 1024.f) + 1e-6f);
        bf16_t* dst = (bf16_t*)(p.ws + OFF_R1) + (size_t)(row0 + r) * 1024;
#pragma unroll
        for (int i = 0; i < 4; ++i) {
          ushort4 o; o.x = f2bf(v[r][i].x * rstd * wv[i].x); o.y = f2bf(v[r][i].y * rstd * wv[i].y); o.z = f2bf(v[r][i].z * rstd * wv[i].z); o.w = f2bf(v[r][i].w * rstd * wv[i].w);
          *(ushort4*)(dst + (lane + 64 * i) * 4) = o;
        }
      }
    } else if (job < JB_BIAS) {
      const int idx = (job - JB_ROPE) * 256 + tid, t = idx >> 3, i = idx & 7;
      const float ang = (float)p.positions[t] * p.inv_freq[i];
      const double rev = (double)ang * 0.15915494309189533577;
      const float fr = (float)(rev - rint(rev));
      float* rt = (float*)(p.ws + OFF_ROPE);
      rt[idx * 2] = __builtin_amdgcn_cosf(fr); rt[idx * 2 + 1] = __builtin_amdgcn_sinf(fr);
    } else if (job < JB_ZERO) {
      const int jb = job - JB_BIAS, kv = jb >> 4, ch = jb & 15;
      const float* pe = kv ? p.cmp_pe_v : p.cmp_pe_k; const float* w1 = kv ? p.cmp_v_w1 : p.cmp_k_w1;
      float s0 = 0.f, s1 = 0.f, s2 = 0.f, s3 = 0.f;
#pragma unroll 1
      for (int i0 = ch * 128; i0 < ch * 128 + 128; i0 += 32) {
        float wv[32];
#pragma unroll
        for (int u = 0; u < 32; ++u) wv[u] = w1[(size_t)(i0 + u) * 256 + tid];
#pragma unroll
        for (int u = 0; u < 32; u += 4) { s0 += pe[i0 + u] * wv[u]; s1 += pe[i0 + u + 1] * wv[u + 1]; s2 += pe[i0 + u + 2] * wv[u + 2]; s3 += pe[i0 + u + 3] * wv[u + 3]; }
      }
      ((float*)(p.ws + OFF_CB1))[(kv * 16 + ch) * 256 + tid] = (s0 + s1) + (s2 + s3);
    } else if (job == JB_ZERO) {
      if (tid < 32) ((int*)(p.ws + OFF_MISC))[tid] = 0;
      if (tid < 16) ((int*)(p.ws + OFF_MISC))[CNT_IDX(tid)] = 0;
    } else {
      const int col = tid & 31, kbase = (job - JB_ZERO - 1) * 128 + (tid >> 5) * 16;
      uint32_t hi[8], lo[8];
#pragma unroll
      for (int i = 0; i < 8; ++i) {
        float v[2];
#pragma unroll
        for (int h = 0; h < 2; ++h) { const int k = kbase + 2 * i + h; v[h] = col < 4 ? p.rg_w[k * 4 + col] : col < 20 ? p.re_w[k * 16 + col - 4] : 0.f; }
        const bf16_t h0 = f2bf(v[0]), h1 = f2bf(v[1]);
        hi[i] = (uint32_t)h0 | ((uint32_t)h1 << 16);
        lo[i] = (uint32_t)f2bf(v[0] - bf2f(h0)) | ((uint32_t)f2bf(v[1] - bf2f(h1)) << 16);
      }
      bf16_t* wrt = (bf16_t*)(p.ws + OFF_WR);
      uint4* dh = (uint4*)(wrt + (size_t)col * 1024 + kbase); uint4* dl = (uint4*)(wrt + (size_t)(32 + col) * 1024 + kbase);
      dh[0] = make_uint4(hi[0], hi[1], hi[2], hi[3]); dh[1] = make_uint4(hi[4], hi[5], hi[6], hi[7]);
      dl[0] = make_uint4(lo[0], lo[1], lo[2], lo[3]); dl[1] = make_uint4(lo[4], lo[5], lo[6], lo[7]);
    }
  }
}

DI bool prep_deferred(int job) { return (job >= JB_WOUT && job < JB_CW1) || (job >= JB_WG && job < JB_XB); }
constexpr int ND_JOBS = J_WOUT + J_WG + J_WU + J_WDN;
DI void phase_prep(const Params& p, unsigned char* smem) {
  for (int job = J_TOTAL - 1 - (int)blockIdx.x; job >= 0; job -= gridDim.x) if (!prep_deferred(job)) prep_job(p, job, smem);
}

DI void phase_inproj(const Params& p, unsigned char* smem) {
  const bf16_t* xb = (const bf16_t*)(p.ws + OFF_R1);
  const bf16_t* WinT = (const bf16_t*)(p.ws + OFF_WIN);
  const float* rope = (const float*)(p.ws + OFF_ROPE);
  bf16_t* Qn = (bf16_t*)(p.ws + OFF_QN); bf16_t* KV = (bf16_t*)(p.ws + OFF_KV); bf16_t* SB = (bf16_t*)(p.ws + OFF_SB);
  float* gates = (float*)(p.ws + OFF_GATES);
  const int G8 = gridDim.x >> 3, vb = vblock(), xcd = (gridDim.x & 7) ? 0 : vb / G8, vi = (gridDim.x & 7) ? vb : vb % G8, vstep = (gridDim.x & 7) ? gridDim.x : G8;
  const int qmax = (gridDim.x & 7) ? 128 * 23 : 16 * 23;
  for (int q = vi; q < qmax; q += vstep) {
    int rt, ct;
    if (gridDim.x & 7) { rt = q / 23; ct = q % 23; }
    else { const int rg = q / 184, rem = q - rg * 184; ct = rem >> 3; rt = xcd * 16 + rg * 8 + (rem & 7); }
    const int row0 = rt * 128;
    auto epi = [=](f32x4 (&acc)[4][4], int wr, int wc, int lane) {
      const int quad = lane >> 4, lc = lane & 15;
      const int colw = ct * 128 + wc * 64;
      if (colw < 2816) {
        bf16_t* dbase; int ld; bool ropew; float scale = 1.f;
        if (colw < 512) { dbase = Qn + colw; ld = 512; ropew = true; scale = 0.125f * 1.44269504f; }
        else if (colw < 1280) { const int buf = (colw - 512) >> 6; dbase = KV + (size_t)buf * T * 64; ld = 64; ropew = ((buf & 2) == 0) && (buf >= 4); }
        else { const int ih = (colw - 1280) >> 6; dbase = SB + (size_t)ih * T * 64; ld = 64; ropew = false; scale = (ih < 8) ? 0.125f * 1.44269504f : 1.f; }
        float2 csv[4][4];
        if (ropew) {
#pragma unroll
          for (int m = 0; m < 4; ++m)
#pragma unroll
            for (int r = 0; r < 4; ++r) csv[m][r] = *(const float2*)(rope + ((size_t)(row0 + wr * 64 + m * 16 + quad * 4 + r) * 8 + (lc & 7)) * 2);
        }
        bf16_t* patch = (bf16_t*)(smem + ((wr * 2 + wc) * 64 * 72 * 2));
#pragma unroll
        for (int m = 0; m < 4; ++m)
#pragma unroll
          for (int n = 0; n < 4; ++n)
#pragma unroll
            for (int r = 0; r < 4; ++r) {
              float v = acc[m][n][r];
              if (ropew && n == 0) {
                const float pv = shx(v, 8);
                const float2 cs = csv[m][r];
                v = (lc < 8) ? (v * cs.x - pv * cs.y) : (v * cs.x + pv * cs.y);
              }
              patch[(m * 16 + quad * 4 + r) * 72 + n * 16 + lc] = f2bf(v * scale);
            }
        asm volatile("s_waitcnt lgkmcnt(0)" ::: "memory");
#pragma unroll
        for (int i = 0; i < 8; ++i) {
          const int row = (lane >> 3) + 8 * i, ch = lane & 7;
          const uint4 q4 = *(const uint4*)&patch[row * 72 + ch * 8];
          *(uint4*)(dbase + (size_t)(row0 + wr * 64 + row) * ld + ch * 8) = q4;
        }
      } else if (colw < 2880) {
#pragma unroll
        for (int m = 0; m < 4; ++m)
#pragma unroll
          for (int n = 0; n < 2; ++n) {
            const int cgi = colw - 2816 + n * 16 + lc;
            if (cgi < 24) {
#pragma unroll
              for (int r = 0; r < 4; ++r) gates[(size_t)(row0 + wr * 64 + m * 16 + quad * 4 + r) * 24 + cgi] = sigmoidf_(acc[m][n][r]);
            }
          }
      }
    };
    gemm128([=](int r) { return xb + (size_t)(row0 + r) * 1024; }, WinT + (size_t)ct * 128 * 1024, 1024, 1024, epi, smem);
  }
}

DI void phase_cmp1(const Params& p, unsigned char* smem) {
  const bf16_t* KV = (const bf16_t*)(p.ws + OFF_KV);
  bf16_t* HC = (bf16_t*)(p.ws + OFF_HC);
  const float* cb1 = (const float*)(p.ws + OFF_CB1);
  for (int tile = blockIdx.x; tile < 64; tile += gridDim.x) {
    const int kvg = tile >> 4, kv = kvg >> 1, g = kvg & 1, rt = (tile >> 1) & 7, ct = tile & 1;
    const bf16_t* src = KV + (size_t)(kv * 2 + g) * T * 64;
    bf16_t* hc = HC + (size_t)kvg * 1024 * 256;
    auto epi = [=](f32x4 (&acc)[4][4], int wr, int wc, int lane) {
      const int quad = lane >> 4, lc = lane & 15;
#pragma unroll
      for (int m = 0; m < 4; ++m)
#pragma unroll
        for (int n = 0; n < 4; ++n) {
          const int col = ct * 128 + wc * 64 + n * 16 + lc;
          float b = 0.f;
#pragma unroll
          for (int ch = 0; ch < 16; ++ch) b += cb1[(kv * 16 + ch) * 256 + col];
#pragma unroll
          for (int r = 0; r < 4; ++r) {
            const int row = rt * 128 + wr * 64 + m * 16 + quad * 4 + r;
            const float v = acc[m][n][r] + b;
            hc[(size_t)row * 256 + col] = f2bf(v * sigmoidf_(v));
          }
        }
    };
    gemm128([=](int r) { return src + (size_t)(rt * 128 + r) * 1024; }, (const bf16_t*)(p.ws + OFF_CW1) + (size_t)kv * 256 * 2048 + (size_t)ct * 128 * 2048, 2048, 2048, epi, smem);
  }
}
DI void phase_cmp2(const Params& p, unsigned char* smem) {
  const bf16_t* HC = (const bf16_t*)(p.ws + OFF_HC);
  bf16_t* KC = (bf16_t*)(p.ws + OFF_KC);
  for (int tile = blockIdx.x; tile < 32; tile += gridDim.x) {
    const int kvg = tile >> 3, kv = kvg >> 1, rt = tile & 7;
    const bf16_t* hc = HC + (size_t)kvg * 1024 * 256;
    bf16_t* kc = KC + (size_t)kvg * 1024 * 64;
    auto epi = [=](f32x4 (&acc)[4][4], int wr, int wc, int lane) {
      const int quad = lane >> 4, lc = lane & 15;
      if (wc == 0) {
#pragma unroll
        for (int m = 0; m < 4; ++m)
#pragma unroll
          for (int n = 0; n < 4; ++n)
#pragma unroll
            for (int r = 0; r < 4; ++r) {
              const int row = rt * 128 + wr * 64 + m * 16 + quad * 4 + r;
              kc[(size_t)row * 64 + n * 16 + lc] = f2bf(acc[m][n][r]);
            }
      }
    };
    gemm128([=](int r) { return hc + (size_t)(rt * 128 + r) * 256; }, (const bf16_t*)(p.ws + OFF_CW2) + (size_t)kv * 128 * 256, 256, 256, epi, smem);
  }
}

DI void dot4(const float* qs, const bf16_t* krow, float (&s)[4]) {
  s[0] = s[1] = s[2] = s[3] = 0.f;
#pragma unroll
  for (int c = 0; c < 8; ++c) {
    const uint4 u = ((const uint4*)krow)[c];
    const float f[8] = {bflo(u.x), bfhi(u.x), bflo(u.y), bfhi(u.y), bflo(u.z), bfhi(u.z), bflo(u.w), bfhi(u.w)};
#pragma unroll
    for (int e = 0; e < 8; ++e) {
#pragma unroll
      for (int r = 0; r < 4; ++r) s[r] += qs[r * 64 + c * 8 + e] * f[e];
    }
  }
}
DI float dot1(const float* qs, const bf16_t* krow) {
  float s = 0.f;
#pragma unroll
  for (int c = 0; c < 8; ++c) {
    const uint4 u = ((const uint4*)krow)[c];
    const float f[8] = {bflo(u.x), bfhi(u.x), bflo(u.y), bfhi(u.y), bflo(u.z), bfhi(u.z), bflo(u.w), bfhi(u.w)};
#pragma unroll
    for (int e = 0; e < 8; ++e) s += qs[c * 8 + e] * f[e];
  }
  return s;
}

DI void attend_chunk(const float* qs, const bf16_t* K, const bf16_t* V, int key0, int t, int lane,
                     float (&mr)[4], float (&lr)[4], float (&orr)[4]) {
  const int key = key0 + lane;
  const bool valid = key <= t;
  const int kc = key < T ? key : T - 1;
  float s[4];
  dot4(qs + opaque0(), K + (size_t)kc * 64, s);
  s[0] *= 0.69314718f; s[1] *= 0.69314718f; s[2] *= 0.69314718f; s[3] *= 0.69314718f;
  float pr[4];
#pragma unroll
  for (int r = 0; r < 4; ++r) {
    const float sv = valid ? s[r] : -INFINITY;
    const float cm = wave_max(sv);
    const float mn = fmaxf(mr[r], cm);
    const float alpha = __expf(mr[r] - mn);
    pr[r] = valid ? __expf(sv - mn) : 0.f;
    lr[r] = lr[r] * alpha + wave_sum(pr[r]);
    mr[r] = mn;
    orr[r] *= alpha;
  }
#pragma unroll 2
  for (int i = 0; i < 64; ++i) {
    int ki = key0 + i; ki = ki < T ? ki : T - 1;
    const float v = bf2f(V[(size_t)ki * 64 + lane]);
#pragma unroll
    for (int r = 0; r < 4; ++r) orr[r] += rdlane(pr[r], i) * v;
  }
}

constexpr int ATT_NSA_JOBS = T * 2 / 4;
constexpr int ATT_SB_JOBS  = T * 8 / 4;
DI void phase_attn(const Params& p, unsigned char* smem) {
  const int tid = tidx(), lane = tid & 63, w = tid >> 6;
  float* wsm = (float*)smem + w * 2304;
  float* qs = wsm; float* sc = wsm + 256; float* ps = wsm + 1280;
  const bf16_t* Qn = (const bf16_t*)(p.ws + OFF_QN); const bf16_t* KV = (const bf16_t*)(p.ws + OFF_KV); const bf16_t* SB = (const bf16_t*)(p.ws + OFF_SB);
  const bf16_t* KC = (const bf16_t*)(p.ws + OFF_KC);
  const float* gates = (const float*)(p.ws + OFF_GATES);
  float* omix = (float*)(p.ws + OFF_R3);
  for (int job = blockIdx.x; job < ATT_NSA_JOBS + ATT_SB_JOBS; job += gridDim.x) {
    if (job < ATT_NSA_JOBS) {
      const int item = job * 4 + w, t = item >> 1, g = item & 1;
      for (int i = lane; i < 256; i += 64) qs[i] = bf2f(Qn[(size_t)t * 512 + g * 256 + i]);
      for (int i = lane; i < 1024; i += 64) ps[i] = 0.f;
      const bf16_t* kc = KC + (size_t)(0 * 2 + g) * 1024 * 64;
      const bf16_t* vc = KC + (size_t)(1 * 2 + g) * 1024 * 64;
      int nv = t >= 31 ? ((t - 31) >> 4) + 1 : 0; if (nv > NCMP) nv = NCMP;
      float oc[4];
#pragma nounroll
      for (int r = 0; r < 4; ++r) {
        float mx = -INFINITY;
#pragma nounroll
        for (int n = lane; n < nv; n += 64) { const float s = 0.69314718f * dot1(qs + r * 64 + opaque0(), kc + (size_t)n * 64); sc[n] = s; mx = fmaxf(mx, s); }
        mx = wave_max(mx);
        float sum = 0.f;
        for (int n = lane; n < nv; n += 64) { const float e = __expf(sc[n] - mx); sc[n] = e; sum += e; }
        sum = wave_sum(sum);
        const float inv = nv > 0 ? 1.f / fmaxf(sum, 1e-30f) : 0.f;
        for (int n = lane; n < nv; n += 64) { const float pr = sc[n] * inv; sc[n] = pr; ps[n] += pr; }
        float o = 0.f;
#pragma unroll 4
        for (int n = 0; n < nv; ++n) o += sc[n] * bf2f(vc[(size_t)n * 64 + lane]);
        if (r == 0) oc[0] = o; else if (r == 1) oc[1] = o; else if (r == 2) oc[2] = o; else oc[3] = o;
      }
      const int bq = t >> 6;
      float cand[4];
#pragma unroll
      for (int i = 0; i < 4; ++i) {
        const int m = lane + 64 * i;
        float imp = 0.f;
#pragma unroll
        for (int dn = -1; dn <= 3; ++dn) { const int n = 4 * m + dn; if (n >= 0 && n < NCMP) imp += ps[n]; }
        const bool allowed = m <= bq, forced = (m == 0) || (m == bq) || (m == bq - 1);
        cand[i] = allowed ? imp + (forced ? 1.0e4f : 0.f) : -1e30f;
      }
      int* selidx = (int*)sc;
      for (int k = 0; k < 16; ++k) {
        float bv = cand[0]; int bi = lane;
#pragma unroll
        for (int i = 1; i < 4; ++i) if (cand[i] > bv) { bv = cand[i]; bi = lane + 64 * i; }
        for (int o = 32; o; o >>= 1) {
          const float ov = __shfl_xor(bv, o); const int oi = __shfl_xor(bi, o);
          if (ov > bv || (ov == bv && oi < bi)) { bv = ov; bi = oi; }
        }
#pragma unroll
        for (int i = 0; i < 4; ++i) if (bi == lane + 64 * i) cand[i] = -3.0e38f;
        if (lane == 0) selidx[k] = bi;
      }
      float mr[4], lr[4], osel[4];
#pragma unroll
      for (int r = 0; r < 4; ++r) { mr[r] = -INFINITY; lr[r] = 0.f; osel[r] = 0.f; }
      {
        const bf16_t* K = KV + (size_t)(1 * 4 + 0 * 2 + g) * T * 64; const bf16_t* V = KV + (size_t)(1 * 4 + 1 * 2 + g) * T * 64;
#pragma nounroll
        for (int k = 0; k < 16; ++k) {
          const int j = __builtin_amdgcn_readfirstlane(selidx[k]);
          if (j > bq) continue;
          attend_chunk(qs, K, V, j * 64, t, lane, mr, lr, osel);
        }
#pragma unroll
        for (int r = 0; r < 4; ++r) osel[r] = osel[r] / fmaxf(lr[r], 1e-30f);
      }
      float owin[4];
#pragma unroll
      for (int r = 0; r < 4; ++r) { mr[r] = -INFINITY; lr[r] = 0.f; owin[r] = 0.f; }
      {
        const bf16_t* K = KV + (size_t)(2 * 4 + 0 * 2 + g) * T * 64; const bf16_t* V = KV + (size_t)(2 * 4 + 1 * 2 + g) * T * 64;
        const int lo = t - 511 > 0 ? t - 511 : 0;
#pragma nounroll
        for (int k0 = lo; k0 <= t; k0 += 64) attend_chunk(qs, K, V, k0, t, lane, mr, lr, owin);
#pragma unroll
        for (int r = 0; r < 4; ++r) owin[r] = owin[r] / fmaxf(lr[r], 1e-30f);
      }
#pragma unroll
      for (int r = 0; r < 4; ++r) {
        const int h = g * 4 + r;
        const float* gt = gates + (size_t)t * 24 + h * 3;
        omix[(size_t)t * 1024 + h * 64 + lane] = gt[0] * oc[r] + gt[1] * osel[r] + gt[2] * owin[r];
      }
    } else {
      const int item = (job - ATT_NSA_JOBS) * 4 + w, t = item >> 3, h = item & 7;
      const bf16_t* Q = SB + (size_t)(0 * 8 + h) * T * 64; const bf16_t* K = SB + (size_t)(1 * 8 + h) * T * 64; const bf16_t* V = SB + (size_t)(2 * 8 + h) * T * 64;
      qs[lane] = bf2f(Q[(size_t)t * 64 + lane]);
      float carry = 0.f, o = 0.f;
      for (int c0 = t - 1; c0 >= 0; c0 -= 64) {
        const int s = c0 - lane; const bool valid = s >= 0;
        const float z = 0.69314718f * dot1(qs + opaque0(), K + (size_t)(valid ? s : 0) * 64);
        const float sp = fmaxf(z, 0.f) + log1pf(__expf(-fabsf(z)));
        const float ln = valid ? -sp : 0.f;
        float incl = ln;
        for (int o2 = 1; o2 < 64; o2 <<= 1) { const float u = __shfl_up(incl, o2); if (lane >= o2) incl += u; }
        const float la = z + ln + (incl - ln) + carry;
        const float a = valid ? __expf(la) : 0.f;
        carry += rdlane(incl, 63);
#pragma unroll 4
        for (int i = 0; i < 64; ++i) { int si = c0 - i; si = si > 0 ? si : 0; o += rdlane(a, i) * bf2f(V[(size_t)si * 64 + lane]); }
        if (carry < -104.f) break;
      }
      omix[(size_t)t * 1024 + 512 + h * 64 + lane] = o;
    }
  }
}

using s16x4 = __attribute__((ext_vector_type(4))) short;
using u32x4 = __attribute__((ext_vector_type(4))) unsigned;
typedef __bf16 bf16v2 __attribute__((ext_vector_type(2)));
typedef float f32v2 __attribute__((ext_vector_type(2)));
#define LDS_AS __attribute__((address_space(3)))
DI uint32_t pk2(float a, float b) { f32v2 x = {a, b}; return __builtin_bit_cast(uint32_t, __builtin_convertvector(x, bf16v2)); }
DI bf16x8 pack8(f32x4 a, f32x4 b) { u32x4 r = {pk2(a[0], a[1]), pk2(a[2], a[3]), pk2(b[0], b[1]), pk2(b[2], b[3])}; return __builtin_bit_cast(bf16x8, r); }
DI s16x4 tr_read(const bf16_t* p) { return __builtin_amdgcn_ds_read_tr16_b64_v4i16((LDS_AS s16x4*)p); }
DI f32x4 mfma16(bf16x8 a, bf16x8 b, f32x4 c) { return __builtin_amdgcn_mfma_f32_16x16x32_bf16(a, b, c, 0, 0, 0); }

constexpr float SM_THR = 11.5f;
DI float ex2(float x) { return __builtin_amdgcn_exp2f(x); }
constexpr int KST = 80;
constexpr int L_STAGE = 2 * 64 * KST * 2;
constexpr int L_Q     = 2 * L_STAGE;
constexpr int L_SELM  = L_Q + 256 * 64 * 2;
constexpr int L_QUADM = L_SELM + 64 * 8 * 4;
constexpr int L_BLKM  = L_QUADM + 16 * 8 * 4;
constexpr int L_VOTE  = L_BLKM + 32;
constexpr int L_JLIST = L_VOTE + 64;
constexpr int ATT_LDS = L_JLIST + 1024;
constexpr int NQ = 2;
constexpr int QPI = 16 * NQ;
constexpr int NSA_ITEMS = (T / QPI) * 2, SB_ITEMS = 2048;

#define STAGE_LOAD(LV, Kg, Vg, key0) do { const unsigned off_ = (unsigned)((((key0) + (tid >> 2)) * 64 + (tid & 3) * 16) * 2); \
    const uint4* kp_ = (const uint4*)((const unsigned char*)(Kg) + off_); rk0 = kp_[0]; rk1 = kp_[1]; \
    if (LV) { const uint4* vp_ = (const uint4*)((const unsigned char*)(Vg) + off_); rv0 = vp_[0]; rv1 = vp_[1]; } } while (0)
#define STAGE_STORE(LV, Ks, Vs) do { const int row_ = tid >> 2, c_ = (tid & 3) * 16; \
    *(uint4*)&(Ks)[row_ * KST + c_] = rk0; *(uint4*)&(Ks)[row_ * KST + c_ + 8] = rk1; \
    if (LV) { *(uint4*)&(Vs)[row_ * KST + c_] = rv0; *(uint4*)&(Vs)[row_ * KST + c_ + 8] = rv1; } } while (0)
DI bf16_t* stageK(unsigned char* lds, int s) { return (bf16_t*)(lds + s * L_STAGE); }
DI bf16_t* stageV(unsigned char* lds, int s) { return (bf16_t*)(lds + s * L_STAGE + 64 * KST * 2); }

struct NsaW {
  f32x4 o[4][4];
  float m[4];
  f32x4 l[4];
  float aux[4];
  float prev3[4];
  int tbase;
  int q0;
};

template <int MODE>
DI void nsa_compute(NsaW& W, const bf16_t* Ks, const bf16_t* Vs, int j, int lane, int w, unsigned char* lds, float* impw) {
  const int col = lane & 15, kq = lane >> 4;
  const int key0 = j * 64;
  const uint32_t* selm = (const uint32_t*)(lds + L_SELM);
  const uint32_t* quadm = (const uint32_t*)(lds + L_QUADM) + w * (NQ * 8);
  const bf16_t* Qs = (const bf16_t*)(lds + L_Q) + (w * (NQ * 16) + col) * 64;
  const int qsw = (col >> 1) & 7;
  uint32_t qact = 0xfu, csel = 0xfu;
  if (MODE == 2) {
    const uint32_t* sr = selm + (w * (NQ * 4) + (col >> 2)) * 8 + (j >> 5);
    const int sh = j & 31;
    uint32_t qa = 0u, cs = 0u;
#pragma unroll
    for (int qd = 0; qd < NQ; ++qd) { qa |= ((quadm[qd * 8 + (j >> 5)] >> sh) & 1u) << qd; cs |= ((sr[qd * 32] >> sh) & 1u) << qd; }
    qact = __builtin_amdgcn_readfirstlane(qa); csel = cs;
    if (qact == 0u) return;
  }
  bf16x8 ka[4][2];
#pragma unroll
  for (int kt = 0; kt < 4; ++kt)
#pragma unroll
    for (int ks = 0; ks < 2; ++ks) ka[kt][ks] = *(const bf16x8*)&Ks[(kt * 16 + col) * KST + ks * 32 + kq * 8];
  const bf16_t* vbase = &Vs[(4 * kq + (col >> 2)) * KST + 4 * (col & 3)];
#pragma unroll
  for (int quad = 0; quad < NQ; ++quad) {
    if (MODE == 2) { if (!((qact >> quad) & 1u)) continue; }
    const int t = W.tbase + 4 * quad;
    const int q0i = W.q0;
    bool needmask;
    if (MODE == 0 || MODE == 1) needmask = (key0 + 63) * 16 + 31 > q0i;
    else if (MODE == 2) needmask = key0 + 63 > q0i;
    else needmask = (key0 + 63 > q0i) || (key0 < q0i + QPI - 1 - 511);
    const bool colsel = (MODE != 2) || ((csel >> quad) & 1u);
    const float mq = W.m[quad];
    const bool uninit = mq < -1e29f;
    const float c0 = uninit ? 0.f : mq;
    float cneg = -c0;
    if (MODE == 2 && !colsel) cneg = -INFINITY;
    if (MODE == 1 && uninit) cneg = -INFINITY;
    f32x4 s[4];
    {
      const bf16x8 q0 = *(const bf16x8*)&Qs[quad * 16 * 64 + ((kq ^ qsw) * 8)];
      const bf16x8 q1 = *(const bf16x8*)&Qs[quad * 16 * 64 + (((4 + kq) ^ qsw) * 8)];
#pragma unroll
      for (int kt = 0; kt < 4; ++kt) {
        s[kt] = (f32x4){cneg, cneg, cneg, cneg};
        s[kt] = mfma16(ka[kt][0], q0, s[kt]);
        s[kt] = mfma16(ka[kt][1], q1, s[kt]);
      }
    }
    if (needmask) {
#pragma unroll
      for (int kt = 0; kt < 4; ++kt)
#pragma unroll
        for (int r = 0; r < 4; ++r) {
          const int key = key0 + kt * 16 + 4 * kq + r;
          bool v;
          if (MODE == 0 || MODE == 1) v = key * 16 + 31 <= t;
          else if (MODE == 2) v = key <= t;
          else v = (key <= t) && (key >= t - 511);
          s[kt][r] = v ? s[kt][r] : -INFINITY;
        }
    }
    f32x4 p[4];
    if (MODE == 1) {
      const float il = W.aux[quad];
#pragma unroll
      for (int kt = 0; kt < 4; ++kt)
#pragma unroll
        for (int r = 0; r < 4; ++r) p[kt][r] = ex2(s[kt][r]) * il;
    } else {
      float mloc = fmaxf(fmaxf(fmaxf(s[0][0], s[0][1]), fmaxf(s[0][2], s[0][3])), fmaxf(fmaxf(s[1][0], s[1][1]), fmaxf(s[1][2], s[1][3])));
      mloc = fmaxf(mloc, fmaxf(fmaxf(fmaxf(s[2][0], s[2][1]), fmaxf(s[2][2], s[2][3])), fmaxf(fmaxf(s[3][0], s[3][1]), fmaxf(s[3][2], s[3][3]))));
      if (__any(mloc > (uninit ? -INFINITY : SM_THR))) {
        float mx = fmaxf(mloc, shx(mloc, 16)); mx = fmaxf(mx, shx(mx, 32));
        const bool upd = mx > -INFINITY;
        const float d = upd ? (uninit ? mx : fmaxf(mx, 0.f)) : 0.f;
#pragma unroll
        for (int kt = 0; kt < 4; ++kt) s[kt] = s[kt] - d;
        if (upd) W.m[quad] = c0 + d;
        const float alpha = uninit ? 1.f : ex2(-d);
        W.l[quad] = W.l[quad] * alpha;
        if (MODE != 0) {
#pragma unroll
          for (int dt = 0; dt < 4; ++dt) W.o[quad][dt] *= alpha;
        }
      }
#pragma unroll
      for (int kt = 0; kt < 4; ++kt)
#pragma unroll
        for (int r = 0; r < 4; ++r) p[kt][r] = ex2(s[kt][r]);
    }
    const bf16x8 pb0 = pack8(p[0], p[1]), pb1 = pack8(p[2], p[3]);
    if (MODE != 1) {
      const bf16x8 ones = {0x3F80, 0x3F80, 0x3F80, 0x3F80, 0x3F80, 0x3F80, 0x3F80, 0x3F80};
      W.l[quad] = mfma16(ones, pb0, W.l[quad]);
      W.l[quad] = mfma16(ones, pb1, W.l[quad]);
    }
    if (MODE == 0) continue;
    if (MODE == 1) {
#pragma unroll
      for (int kt = 0; kt < 4; ++kt) {
        f32x4 ps = p[kt];
#pragma unroll
        for (int r = 0; r < 4; ++r) { ps[r] += dppx1(ps[r]); ps[r] += dppx2(ps[r]); }
        const int mi = j * 16 + kt * 4 + kq;
        if ((col & 3) == 0) {
          float* row = (float*)((unsigned char*)impw + (unsigned)((quad * 4 + (col >> 2)) * 512 * 4));
          row[mi] = ps[0] + ps[1] + ps[2] + ps[3];
          if (mi < 255) row[256 + mi + 1] = ps[3];
        }
      }
    }
#pragma unroll
    for (int dt = 0; dt < 4; ++dt) {
#pragma unroll
      for (int s2 = 0; s2 < 2; ++s2) {
        const bf16_t* p0 = vbase + (2 * s2) * 16 * KST + dt * 16;
        const s16x4 lo = tr_read(p0), hi = tr_read(p0 + 16 * KST);
        W.o[quad][dt] = mfma16(__builtin_shufflevector(lo, hi, 0, 1, 2, 3, 4, 5, 6, 7), s2 ? pb1 : pb0, W.o[quad][dt]);
      }
    }
  }
}

#define STAGE_LOAD2(S, LV, Kg, Vg, key0) do { const unsigned off_ = (unsigned)((((key0) + (tid >> 2)) * 64 + (tid & 3) * 16) * 2); \
    const uint4* kp_ = (const uint4*)((const unsigned char*)(Kg) + off_); S##k0 = kp_[0]; S##k1 = kp_[1]; \
    if (LV) { const uint4* vp_ = (const uint4*)((const unsigned char*)(Vg) + off_); S##v0 = vp_[0]; S##v1 = vp_[1]; } } while (0)
#define STAGE_STORE2(S, LV, Ks, Vs) do { const int row_ = tid >> 2, c_ = (tid & 3) * 16; \
    *(uint4*)&(Ks)[row_ * KST + c_] = S##k0; *(uint4*)&(Ks)[row_ * KST + c_ + 8] = S##k1; \
    if (LV) { *(uint4*)&(Vs)[row_ * KST + c_] = S##v0; *(uint4*)&(Vs)[row_ * KST + c_ + 8] = S##v1; } } while (0)
template <int MODE, class JAt>
DI void nsa_stream(NsaW& W, const bf16_t* Kg, const bf16_t* Vg, JAt jat, int n, unsigned char* lds, int tid, int lane, int w, float* impw) {
  constexpr bool LV = (MODE != 0);
  if (n <= 0) return;
  uint4 Ak0, Ak1, Av0 = make_uint4(0, 0, 0, 0), Av1 = make_uint4(0, 0, 0, 0), Bk0 = make_uint4(0, 0, 0, 0), Bk1 = make_uint4(0, 0, 0, 0), Bv0 = make_uint4(0, 0, 0, 0), Bv1 = make_uint4(0, 0, 0, 0);
  STAGE_LOAD2(A, LV, Kg, Vg, jat(0) * 64);
  STAGE_STORE2(A, LV, stageK(lds, 0), stageV(lds, 0));
  if (n > 1) STAGE_LOAD2(A, LV, Kg, Vg, jat(1) * 64);
  if (n > 2) STAGE_LOAD2(B, LV, Kg, Vg, jat(2) * 64);
  __syncthreads();
  int i = 0;
  for (;;) {
    nsa_compute<MODE>(W, stageK(lds, 0), stageV(lds, 0), jat(i), lane, w, lds, impw);
    if (i + 1 < n) STAGE_STORE2(A, LV, stageK(lds, 1), stageV(lds, 1));
    __syncthreads();
    if (i + 1 >= n) break;
    if (i + 3 < n) STAGE_LOAD2(A, LV, Kg, Vg, jat(i + 3) * 64);
    ++i;
    nsa_compute<MODE>(W, stageK(lds, 1), stageV(lds, 1), jat(i), lane, w, lds, impw);
    if (i + 1 < n) STAGE_STORE2(B, LV, stageK(lds, 0), stageV(lds, 0));
    __syncthreads();
    if (i + 1 >= n) break;
    if (i + 3 < n) STAGE_LOAD2(B, LV, Kg, Vg, jat(i + 3) * 64);
    ++i;
  }
}

DI int next_bit(const uint32_t* bm, int prev) {
  int j = prev + 1;
  while (j < 256) {
    const uint32_t wd = bm[j >> 5] >> (j & 31);
    if (wd) return j + __builtin_ctz(wd);
    j = (j | 31) + 1;
  }
  return -1;
}

DI void nsa_item(const Params& p, int item, unsigned char* lds, float* omix, int tid) {
  const int lane = tid & 63, w = __builtin_amdgcn_readfirstlane(tid >> 6), col = lane & 15, kq = lane >> 4;
  const int g = item & 1, q0 = (T / QPI - 1 - (item >> 1)) * QPI, bq = q0 >> 6;
  const bf16_t* Qn = (const bf16_t*)(p.ws + OFF_QN);
  const bf16_t* KV = (const bf16_t*)(p.ws + OFF_KV);
  const bf16_t* KC = (const bf16_t*)(p.ws + OFF_KC);
  const float* gates = (const float*)(p.ws + OFF_GATES);
  uint32_t* selm = (uint32_t*)(lds + L_SELM);
  uint32_t* quadm = (uint32_t*)(lds + L_QUADM);
  uint32_t* blkm = (uint32_t*)(lds + L_BLKM);
  unsigned char* jlist = lds + L_JLIST;
  float* impw = (float*)(p.ws + OFF_R1) + ((size_t)blockIdx.x * 4 + w) * (NQ * 4) * 512;
  if (tid < QPI * 4) {
    const uint4* src = (const uint4*)(Qn + (size_t)(q0 + (tid >> 2)) * 512 + g * 256 + (tid & 3) * 64);
    bf16_t* dst = (bf16_t*)(lds + L_Q) + tid * 64;
    const int sw = ((tid & 15) >> 1) & 7;
#pragma unroll
    for (int c = 0; c < 8; ++c) *(uint4*)&dst[(c ^ sw) * 8] = src[c];
  }
  NsaW W;
  W.tbase = q0 + w * (NQ * 4) + (col >> 2);
  W.q0 = q0;
#pragma unroll
  for (int quad = 0; quad < NQ; ++quad) {
    W.m[quad] = -1e30f; W.l[quad] = (f32x4){0.f, 0.f, 0.f, 0.f}; W.prev3[quad] = 0.f; W.aux[quad] = 0.f;
#pragma unroll
    for (int dt = 0; dt < 4; ++dt) W.o[quad][dt] = (f32x4){0.f, 0.f, 0.f, 0.f};
  }
  __syncthreads();
  int nvmax = ((q0 + QPI - 1 - 31) >> 4) + 1; if (nvmax < 0) nvmax = 0; nvmax = nvmax < NCMP ? nvmax : NCMP;
  const int nblk = (nvmax + 63) >> 6;
  const bf16_t* kc = KC + (size_t)(0 * 2 + g) * 1024 * 64;
  const bf16_t* vc = KC + (size_t)(1 * 2 + g) * 1024 * 64;
  auto jseq = [=](int i) { return i; };
  nsa_stream<0>(W, kc, vc, jseq, nblk, lds, tid, lane, w, impw);
#pragma unroll
  for (int quad = 0; quad < NQ; ++quad) {
    const float lt = W.l[quad][0];
    W.aux[quad] = lt > 0.f ? 1.f / lt : 0.f;
  }
  for (int i = lane; i < NQ * 4 * 8; i += 64) selm[w * (NQ * 32) + i] = 0u;
  nsa_stream<1>(W, kc, vc, jseq, nblk, lds, tid, lane, w, impw);
#pragma unroll
  for (int quad = 0; quad < NQ; ++quad) {
    __builtin_amdgcn_sched_barrier(0);
    const int t = W.tbase + 4 * quad + opaque0(), head = g * 4 + (col & 3);
    const float g0 = gates[(size_t)t * 24 + head * 3 + 0];
#pragma unroll
    for (int dt = 0; dt < 4; ++dt) {
      const f32x4 v = W.o[quad][dt] * g0;
      *(uint2*)((bf16_t*)omix + (size_t)t * 1024 + head * 64 + dt * 16 + kq * 4) = make_uint2(pk2(v[0], v[1]), pk2(v[2], v[3]));
    }
  }
  {
    constexpr int LPQ = 64 / (NQ * 4), VPL = 256 / LPQ;
    static_assert(LPQ == 8, "selection written for 8 lanes per query");
    const int qi = lane / LPQ, part = lane % LPQ, m0 = part * VPL;
    uint32_t* myw = selm + (w * (NQ * 4) + qi) * 8;
    if (bq >= 16) {
      float v[VPL];
      const float4* ra = (const float4*)(impw + qi * 512 + m0);
      const float4* rb = (const float4*)(impw + qi * 512 + 256 + m0);
#pragma unroll
      for (int i4 = 0; i4 < VPL / 4; ++i4) {
        const float4 x = ra[i4], y = rb[i4];
        v[4 * i4] = x.x + y.x; v[4 * i4 + 1] = x.y + y.y; v[4 * i4 + 2] = x.z + y.z; v[4 * i4 + 3] = x.w + y.w;
      }
#pragma unroll
      for (int i = 0; i < VPL; ++i) { const int mm = m0 + i; v[i] = (mm >= 1 && mm <= bq - 2) ? v[i] : -1.f; }
#pragma nounroll
      for (int it = 0; it < 13; ++it) {
        float t16[16]; int i16[16];
#pragma unroll
        for (int i = 0; i < 16; ++i) { const bool g = v[2 * i + 1] > v[2 * i]; t16[i] = g ? v[2 * i + 1] : v[2 * i]; i16[i] = g ? 2 * i + 1 : 2 * i; }
        float t8[8]; int i8[8];
#pragma unroll
        for (int i = 0; i < 8; ++i) { const bool g = t16[2 * i + 1] > t16[2 * i]; t8[i] = g ? t16[2 * i + 1] : t16[2 * i]; i8[i] = g ? i16[2 * i + 1] : i16[2 * i]; }
        float t4[4]; int i4[4];
#pragma unroll
        for (int i = 0; i < 4; ++i) { const bool g = t8[2 * i + 1] > t8[2 * i]; t4[i] = g ? t8[2 * i + 1] : t8[2 * i]; i4[i] = g ? i8[2 * i + 1] : i8[2 * i]; }
        const bool g0 = t4[1] > t4[0], g1 = t4[3] > t4[2];
        const float u0 = g0 ? t4[1] : t4[0], u1 = g1 ? t4[3] : t4[2]; const int j0 = g0 ? i4[1] : i4[0], j1 = g1 ? i4[3] : i4[2];
        float best = (u1 > u0) ? u1 : u0; int bi = m0 + ((u1 > u0) ? j1 : j0);
#pragma unroll
        for (int st = 0; st < 3; ++st) {
          const float ov = st == 0 ? dppx1(best) : st == 1 ? dppx2(best) : dpp_hm(best);
          const int oi = __float_as_int(st == 0 ? dppx1(__int_as_float(bi)) : st == 1 ? dppx2(__int_as_float(bi)) : dpp_hm(__int_as_float(bi)));
          if (ov > best || (ov == best && oi < bi)) { best = ov; bi = oi; }
        }
#pragma unroll
        for (int i = 0; i < VPL; ++i) { if (bi == m0 + i) v[i] = -1.f; }
        if (part == 0) myw[bi >> 5] |= 1u << (bi & 31);
      }
      if (part == 0) { myw[0] |= 1u; myw[(bq - 1) >> 5] |= 1u << ((bq - 1) & 31); myw[bq >> 5] |= 1u << (bq & 31); }
    } else {
      if (part == 0) myw[0] = (2u << bq) - 1u;
    }
  }
  __syncthreads();
  if (tid < NQ * 32) { const int qd = tid >> 3, wd = tid & 7; quadm[tid] = selm[(qd * 4 + 0) * 8 + wd] | selm[(qd * 4 + 1) * 8 + wd] | selm[(qd * 4 + 2) * 8 + wd] | selm[(qd * 4 + 3) * 8 + wd]; }
  __syncthreads();
  unsigned char* wlist = lds + L_JLIST + w * 256;
  int nw = 0;
  for (int wd = 0; wd <= (bq >> 5); ++wd) {
    uint32_t u = 0;
#pragma unroll
    for (int qd = 0; qd < NQ; ++qd) u |= quadm[(w * NQ + qd) * 8 + wd];
    u = __builtin_amdgcn_readfirstlane(u);
    if (lane < 32 && ((u >> lane) & 1u)) wlist[nw + __builtin_popcount(u & ((1u << lane) - 1u))] = (unsigned char)(wd * 32 + lane);
    nw += __builtin_popcount(u);
  }
#pragma unroll
  for (int quad = 0; quad < NQ; ++quad) {
    W.m[quad] = -1e30f; W.l[quad] = (f32x4){0.f, 0.f, 0.f, 0.f};
#pragma unroll
    for (int dt = 0; dt < 4; ++dt) W.o[quad][dt] = (f32x4){0.f, 0.f, 0.f, 0.f};
  }
  {
    const bf16_t* K = KV + (size_t)(2 * 4 + 0 * 2 + g) * T * 64; const bf16_t* V = KV + (size_t)(2 * 4 + 1 * 2 + g) * T * 64;
    const int jlo = bq >= 8 ? bq - 8 : 0;
    nsa_stream<3>(W, K, V, [=](int i) { return jlo + i; }, bq - jlo + 1, lds, tid, lane, w, impw);
#pragma unroll
    for (int quad = 0; quad < NQ; ++quad) {
      __builtin_amdgcn_sched_barrier(0);
      const int t = W.tbase + 4 * quad + opaque0(), head = g * 4 + (col & 3);
      const float lt = W.l[quad][0];
      const float sc = gates[(size_t)t * 24 + head * 3 + 2] / fmaxf(lt, 1e-30f);
#pragma unroll
      for (int dt = 0; dt < 4; ++dt) {
        uint2* dst = (uint2*)((bf16_t*)omix + (size_t)t * 1024 + head * 64 + dt * 16 + kq * 4);
        const uint2 ov = *dst;
        const f32x4 nv = (f32x4){bflo(ov.x), bfhi(ov.x), bflo(ov.y), bfhi(ov.y)} + W.o[quad][dt] * sc;
        *dst = make_uint2(pk2(nv[0], nv[1]), pk2(nv[2], nv[3]));
        W.o[quad][dt] = (f32x4){0.f, 0.f, 0.f, 0.f};
      }
      W.m[quad] = -1e30f; W.l[quad] = (f32x4){0.f, 0.f, 0.f, 0.f};
    }
  }
  {
    const bf16_t* Kg = KV + (size_t)(1 * 4 + 0 * 2 + g) * T * 64; const bf16_t* Vg = KV + (size_t)(1 * 4 + 1 * 2 + g) * T * 64;
    unsigned char* R = lds + w * 16384;
    const uint32_t* qm = quadm + w * (NQ * 8);
    const uint32_t* sr = selm + (w * (NQ * 4) + (col >> 2)) * 8;
    bf16x8 qf[NQ][2];
#pragma unroll
    for (int quad = 0; quad < NQ; ++quad)
#pragma unroll
      for (int ks = 0; ks < 2; ++ks) qf[quad][ks] = *(const bf16x8*)(Qn + (size_t)(W.tbase + 4 * quad) * 512 + (g * 4 + (col & 3)) * 64 + ks * 32 + kq * 8);
    const int drow = lane >> 3, dch = lane & 7;
    const int koff = (drow * 64 + ((dch ^ drow) * 8)) * 2;
    const int voff = (drow * 64 + ((dch ^ (((drow >> 1) & 3) << 1)) * 8)) * 2;
#define SEL_DMA(G, dst, VSW) do { const unsigned char* g_ = (const unsigned char*)(G) + ((VSW) ? voff : koff); unsigned char* d_ = (dst) + lane * 16; \
      _Pragma("unroll") for (int i_ = 0; i_ < 8; ++i_) __builtin_amdgcn_global_load_lds((const unsigned*)(g_ + i_ * 1024), (unsigned*)(d_ + i_ * 1024), 16, 0, 0); } while (0)
    const int ksw = col & 7;
    const int vsw = ((2 * kq + (col >> 3)) & 3) << 1;
    if (nw > 0) {
      const int j0 = __builtin_amdgcn_readfirstlane((int)wlist[0]);
      SEL_DMA(Kg + (size_t)j0 * 4096, R, 0);
      SEL_DMA(Vg + (size_t)j0 * 4096, R + 8192, 1);
    }
#pragma nounroll
    for (int i = 0; i < nw; ++i) {
      const int j = __builtin_amdgcn_readfirstlane((int)wlist[i]);
      const bool has_next = i + 1 < nw;
      const int jn = has_next ? __builtin_amdgcn_readfirstlane((int)wlist[i + 1]) : 0;
      const int key0 = j * 64, sh = j & 31;
      uint32_t qa = 0u, cs = 0u;
#pragma unroll
      for (int qd = 0; qd < NQ; ++qd) { qa |= ((qm[qd * 8 + (j >> 5)] >> sh) & 1u) << qd; cs |= ((sr[qd * 32 + (j >> 5)] >> sh) & 1u) << qd; }
      const uint32_t qact = __builtin_amdgcn_readfirstlane(qa);
      const bool diag = key0 + 63 > q0;
      asm volatile("s_waitcnt vmcnt(8)" ::: "memory");
      bf16x8 ka[4][2];
#pragma unroll
      for (int kt = 0; kt < 4; ++kt)
#pragma unroll
        for (int ks = 0; ks < 2; ++ks) ka[kt][ks] = *(const bf16x8*)(R + (kt * 16 + col) * 128 + (((ks * 4 + kq) ^ ksw) * 16));
      asm volatile("s_waitcnt lgkmcnt(0)" ::: "memory");
      if (has_next) SEL_DMA(Kg + (size_t)jn * 4096, R, 0);
      bf16x8 pb[NQ][2];
#pragma unroll
      for (int quad = 0; quad < NQ; ++quad) {
        if (!((qact >> quad) & 1u)) continue;
        const bool colsel = (cs >> quad) & 1u;
        const float mq = W.m[quad];
        const bool uninit = mq < -1e29f;
        const float c0 = uninit ? 0.f : mq;
        const float cneg = colsel ? -c0 : -INFINITY;
        f32x4 s4[4];
#pragma unroll
        for (int kt = 0; kt < 4; ++kt) {
          s4[kt] = (f32x4){cneg, cneg, cneg, cneg};
          s4[kt] = mfma16(ka[kt][0], qf[quad][0], s4[kt]);
          s4[kt] = mfma16(ka[kt][1], qf[quad][1], s4[kt]);
        }
        if (diag) {
          const int t = W.tbase + 4 * quad;
#pragma unroll
          for (int kt = 0; kt < 4; ++kt)
#pragma unroll
            for (int r = 0; r < 4; ++r) s4[kt][r] = (key0 + kt * 16 + 4 * kq + r <= t) ? s4[kt][r] : -INFINITY;
        }
        float mloc = fmaxf(fmaxf(fmaxf(s4[0][0], s4[0][1]), fmaxf(s4[0][2], s4[0][3])), fmaxf(fmaxf(s4[1][0], s4[1][1]), fmaxf(s4[1][2], s4[1][3])));
        mloc = fmaxf(mloc, fmaxf(fmaxf(fmaxf(s4[2][0], s4[2][1]), fmaxf(s4[2][2], s4[2][3])), fmaxf(fmaxf(s4[3][0], s4[3][1]), fmaxf(s4[3][2], s4[3][3]))));
        if (__any(mloc > (uninit ? -INFINITY : SM_THR))) {
          float mx = fmaxf(mloc, shx(mloc, 16)); mx = fmaxf(mx, shx(mx, 32));
          const bool upd = mx > -INFINITY;
          const float d = upd ? (uninit ? mx : fmaxf(mx, 0.f)) : 0.f;
#pragma unroll
          for (int kt = 0; kt < 4; ++kt) s4[kt] = s4[kt] - d;
          if (upd) W.m[quad] = c0 + d;
          const float alpha = uninit ? 1.f : ex2(-d);
          W.l[quad] = W.l[quad] * alpha;
#pragma unroll
          for (int dt = 0; dt < 4; ++dt) W.o[quad][dt] *= alpha;
        }
        f32x4 pp[4];
#pragma unroll
        for (int kt = 0; kt < 4; ++kt)
#pragma unroll
          for (int r = 0; r < 4; ++r) pp[kt][r] = ex2(s4[kt][r]);
        pb[quad][0] = pack8(pp[0], pp[1]); pb[quad][1] = pack8(pp[2], pp[3]);
        const bf16x8 ones = {0x3F80, 0x3F80, 0x3F80, 0x3F80, 0x3F80, 0x3F80, 0x3F80, 0x3F80};
        W.l[quad] = mfma16(ones, pb[quad][0], W.l[quad]);
        W.l[quad] = mfma16(ones, pb[quad][1], W.l[quad]);
      }
      if (has_next) asm volatile("s_waitcnt vmcnt(8)" ::: "memory"); else asm volatile("s_waitcnt vmcnt(0)" ::: "memory");
      bf16x8 va[4][2];
      {
        const unsigned vb_ = (unsigned)(size_t)(R + 8192) + (4 * kq + (col >> 2)) * 128 + (col & 1) * 8;
        const unsigned a0_ = vb_ + (((0 * 2 + ((col & 3) >> 1)) ^ vsw) * 16), a1_ = vb_ + (((1 * 2 + ((col & 3) >> 1)) ^ vsw) * 16),
                       a2_ = vb_ + (((2 * 2 + ((col & 3) >> 1)) ^ vsw) * 16), a3_ = vb_ + (((3 * 2 + ((col & 3) >> 1)) ^ vsw) * 16);
        s16x4 r00, r01, r02, r03, r10, r11, r12, r13, r20, r21, r22, r23, r30, r31, r32, r33;
        asm volatile(
            "ds_read_b64_tr_b16 %0, %16\n\tds_read_b64_tr_b16 %1, %16 offset:2048\n\tds_read_b64_tr_b16 %2, %16 offset:4096\n\tds_read_b64_tr_b16 %3, %16 offset:6144\n\t"
            "ds_read_b64_tr_b16 %4, %17\n\tds_read_b64_tr_b16 %5, %17 offset:2048\n\tds_read_b64_tr_b16 %6, %17 offset:4096\n\tds_read_b64_tr_b16 %7, %17 offset:6144\n\t"
            "ds_read_b64_tr_b16 %8, %18\n\tds_read_b64_tr_b16 %9, %18 offset:2048\n\tds_read_b64_tr_b16 %10, %18 offset:4096\n\tds_read_b64_tr_b16 %11, %18 offset:6144\n\t"
            "ds_read_b64_tr_b16 %12, %19\n\tds_read_b64_tr_b16 %13, %19 offset:2048\n\tds_read_b64_tr_b16 %14, %19 offset:4096\n\tds_read_b64_tr_b16 %15, %19 offset:6144\n\t"
            "s_waitcnt lgkmcnt(0)"
            : "=&v"(r00), "=&v"(r01), "=&v"(r02), "=&v"(r03), "=&v"(r10), "=&v"(r11), "=&v"(r12), "=&v"(r13),
              "=&v"(r20), "=&v"(r21), "=&v"(r22), "=&v"(r23), "=&v"(r30), "=&v"(r31), "=&v"(r32), "=&v"(r33)
            : "v"(a0_), "v"(a1_), "v"(a2_), "v"(a3_) : "memory");
        va[0][0] = __builtin_shufflevector(r00, r01, 0, 1, 2, 3, 4, 5, 6, 7); va[0][1] = __builtin_shufflevector(r02, r03, 0, 1, 2, 3, 4, 5, 6, 7);
        va[1][0] = __builtin_shufflevector(r10, r11, 0, 1, 2, 3, 4, 5, 6, 7); va[1][1] = __builtin_shufflevector(r12, r13, 0, 1, 2, 3, 4, 5, 6, 7);
        va[2][0] = __builtin_shufflevector(r20, r21, 0, 1, 2, 3, 4, 5, 6, 7); va[2][1] = __builtin_shufflevector(r22, r23, 0, 1, 2, 3, 4, 5, 6, 7);
        va[3][0] = __builtin_shufflevector(r30, r31, 0, 1, 2, 3, 4, 5, 6, 7); va[3][1] = __builtin_shufflevector(r32, r33, 0, 1, 2, 3, 4, 5, 6, 7);
      }
      if (has_next) SEL_DMA(Vg + (size_t)jn * 4096, R + 8192, 1);
#pragma unroll
      for (int quad = 0; quad < NQ; ++quad) {
        if (!((qact >> quad) & 1u)) continue;
#pragma unroll
        for (int dt = 0; dt < 4; ++dt) {
          W.o[quad][dt] = mfma16(va[dt][0], pb[quad][0], W.o[quad][dt]);
          W.o[quad][dt] = mfma16(va[dt][1], pb[quad][1], W.o[quad][dt]);
        }
      }
    }
#undef SEL_DMA
#pragma unroll
    for (int quad = 0; quad < NQ; ++quad) {
      __builtin_amdgcn_sched_barrier(0);
      const int t = W.tbase + 4 * quad + opaque0(), head = g * 4 + (col & 3);
      const float lt = W.l[quad][0];
      const float sc = gates[(size_t)t * 24 + head * 3 + 1] / fmaxf(lt, 1e-30f);
#pragma unroll
      for (int dt = 0; dt < 4; ++dt) {
        uint2* dst = (uint2*)((bf16_t*)omix + (size_t)t * 1024 + head * 64 + dt * 16 + kq * 4);
        const uint2 ov = *dst;
        const f32x4 nv = (f32x4){bflo(ov.x), bfhi(ov.x), bflo(ov.y), bfhi(ov.y)} + W.o[quad][dt] * sc;
        *dst = make_uint2(pk2(nv[0], nv[1]), pk2(nv[2], nv[3]));
      }
    }
  }
  __syncthreads();
}

DI void sb_item(const Params& p, int item, unsigned char* lds, float* omix, int tid) {
  const int lane = tid & 63, w = __builtin_amdgcn_readfirstlane(tid >> 6), col = lane & 15, kq = lane >> 4;
  const int bq = item >> 3, h = item & 7, q0 = bq * 64;
  const bf16_t* SB = (const bf16_t*)(p.ws + OFF_SB);
  const bf16_t* Qg = SB + (size_t)(0 * 8 + h) * T * 64; const bf16_t* Kg = SB + (size_t)(1 * 8 + h) * T * 64; const bf16_t* Vg = SB + (size_t)(2 * 8 + h) * T * 64;
  int* vote = (int*)(lds + L_VOTE);
  const int t = q0 + w * 16 + col;
  bf16x8 qf[2];
#pragma unroll
  for (int ks = 0; ks < 2; ++ks) qf[ks] = *(const bf16x8*)(Qg + (size_t)t * 64 + ks * 32 + kq * 8);
  f32x4 o[4];
#pragma unroll
  for (int dt = 0; dt < 4; ++dt) o[dt] = (f32x4){0.f, 0.f, 0.f, 0.f};
  float carry = 0.f;
  int j = bq, cur = 0;
  uint4 rk0, rk1, rv0, rv1;
  STAGE_LOAD(true, Kg, Vg, j * 64);
  STAGE_STORE(true, stageK(lds, 0), stageV(lds, 0));
  __syncthreads();
  while (true) {
    const int jn = j - 1;
    if (jn >= 0) STAGE_LOAD(true, Kg, Vg, jn * 64);
    {
      const bf16_t* Ks = stageK(lds, cur); const bf16_t* Vs = stageV(lds, cur);
      const int key0 = j * 64;
      const bool diag = (j == bq);
      f32x4 a[4];
#pragma unroll
      for (int kt = 3; kt >= 0; --kt) {
        f32x4 z = (f32x4){0.f, 0.f, 0.f, 0.f};
#pragma unroll
        for (int ks = 0; ks < 2; ++ks) z = mfma16(*(const bf16x8*)&Ks[(kt * 16 + col) * KST + ks * 32 + kq * 8], qf[ks], z);
        float ln[4];
#pragma unroll
        for (int rr = 0; rr < 4; ++rr) {
          const float sp = fmaxf(z[rr], 0.f) + __builtin_amdgcn_logf(1.f + ex2(-fabsf(z[rr])));
          ln[rr] = -sp;
        }
        if (diag) {
#pragma unroll
          for (int rr = 0; rr < 4; ++rr) { const bool vd = key0 + kt * 16 + 4 * kq + rr < t; ln[rr] = vd ? ln[rr] : 0.f; z[rr] = vd ? z[rr] : -INFINITY; }
        }
        const float e2 = ln[3], e1 = e2 + ln[2], e0 = e1 + ln[1], tot = e0 + ln[0];
        const float b = px16(tot), c = tot + b, d = px32(c);
        const float base = carry + ((kq & 1) ? 0.f : b) + ((kq & 2) ? 0.f : d);
        a[kt][3] = ex2(z[3] + ln[3] + base);
        a[kt][2] = ex2(z[2] + ln[2] + e2 + base);
        a[kt][1] = ex2(z[1] + ln[1] + e1 + base);
        a[kt][0] = ex2(z[0] + ln[0] + e0 + base);
        carry += c + d;
      }
      const bf16x8 pb0 = pack8(a[0], a[1]), pb1 = pack8(a[2], a[3]);
#pragma unroll
      for (int dt = 0; dt < 4; ++dt)
#pragma unroll
        for (int s2 = 0; s2 < 2; ++s2) {
          const bf16_t* p0 = &Vs[((2 * s2) * 16 + 4 * kq + (col >> 2)) * KST + dt * 16 + 4 * (col & 3)];
          const s16x4 lo = tr_read(p0), hi = tr_read(p0 + 16 * KST);
          o[dt] = mfma16(__builtin_shufflevector(lo, hi, 0, 1, 2, 3, 4, 5, 6, 7), s2 ? pb1 : pb0, o[dt]);
        }
      const int done = __all(carry < -150.1f);
      if (lane == 0) vote[cur * 4 + w] = done;
    }
    if (jn >= 0) STAGE_STORE(true, stageK(lds, cur ^ 1), stageV(lds, cur ^ 1));
    __syncthreads();
    if (jn < 0) break;
    if (vote[cur * 4 + 0] & vote[cur * 4 + 1] & vote[cur * 4 + 2] & vote[cur * 4 + 3]) break;
    cur ^= 1; j = jn;
  }
#pragma unroll
  for (int dt = 0; dt < 4; ++dt) *(uint2*)((bf16_t*)omix + (size_t)t * 1024 + 512 + h * 64 + dt * 16 + kq * 4) = make_uint2(pk2(o[dt][0], o[dt][1]), pk2(o[dt][2], o[dt][3]));
  __syncthreads();
}

DI void phase_attn_mfma(const Params& p, unsigned char* lds, float* omix, int qsel = 0) {
  int* queue = (int*)(p.ws + OFF_MISC) + 16 + qsel;
  int* slot = (int*)(lds + L_VOTE + 32);
  for (;;) {
    if (tidx() == 0) *slot = atomicAdd(queue, 1);
    __syncthreads();
    const int item = *slot;
    __syncthreads();
    constexpr int NINT = NSA_ITEMS * 4, NCV_INT = NSA_ITEMS * 3, NCV_REST = ND_JOBS > NCV_INT ? ND_JOBS - NCV_INT : 0;
    if (item >= NINT + NCV_REST + SB_ITEMS) break;
    const int tidq = tidx() + opaque0();
    int cv = -1;
    if (item < NINT) { if ((item & 3) == 0) nsa_item(p, item >> 2, lds, omix, tidq); else { cv = (item >> 2) * 3 + (item & 3) - 1; if (cv >= ND_JOBS) cv = -1; } }
    else if (item < NINT + NCV_REST) cv = NCV_INT + (item - NINT);
    else sb_item(p, item - NINT - NCV_REST, lds, omix, tidq);
    if (cv >= 0) prep_job(p, cv < J_WOUT ? JB_WOUT + cv : JB_WG + (cv - J_WOUT), lds);
  }
}

DI void phase_mixnorm(const Params& p, unsigned char* smem) {
  const int lane = tidx() & 63, w = tidx() >> 6;
  const bf16_t* omix = (const bf16_t*)(p.ws + OFF_R3);
  unsigned char* ao = p.ws + OFF_R1;
  for (int job = blockIdx.x; job < T / 4; job += gridDim.x) {
    const int row = job * 4 + w;
    const uint2* r4 = (const uint2*)(omix + (size_t)row * 1024);
    float4 v[4]; float s0 = 0.f, s1 = 0.f;
#pragma unroll
    for (int i = 0; i < 4; ++i) {
      const uint2 u = r4[lane + 64 * i];
      v[i] = make_float4(bflo(u.x), bfhi(u.x), bflo(u.y), bfhi(u.y));
      const float q = v[i].x * v[i].x + v[i].y * v[i].y + v[i].z * v[i].z + v[i].w * v[i].w;
      if (i < 2) s0 += q; else s1 += q;
    }
    s0 = wave_sum(s0); s1 = wave_sum(s1);
    const float r0 = rsqrtf(s0 * (1.f / 512.f) + 1e-6f), r1 = rsqrtf(s1 * (1.f / 512.f) + 1e-6f);
#pragma unroll
    for (int i = 0; i < 4; ++i) {
      const float rs = i < 2 ? r0 : r1;
      *(uint32_t*)(ao + (size_t)row * 1024 + (lane + 64 * i) * 4) = pk4_fp8(v[i].x * rs, v[i].y * rs, v[i].z * rs, v[i].w * rs);
    }
  }
}

DI void phase_outproj(const Params& p, unsigned char* smem) {
  const unsigned char* ao = p.ws + OFF_R1;
  const unsigned char* WoutT = p.ws + OFF_WOUT;
  for (int tile = vblock(); tile < 128 * 8; tile += gridDim.x) {
    const int rt = tile >> 3, ct = tile & 7, row0 = rt * 128;
    const float* x = p.x; bf16_t* x1b = (bf16_t*)(p.ws + OFF_X1B);
    auto epi = [=](f32x4 (&acc)[4][4], int wr, int wc, int lane) {
      const int quad = lane >> 4, lc = lane & 15;
      const size_t gbase = (size_t)(row0 + wr * 64 + quad) * 1024 + ct * 128 + wc * 64 + lc * 4;
      float4 xr[16];
#pragma unroll
      for (int i = 0; i < 16; ++i) xr[i] = *(const float4*)(x + gbase + (size_t)(4 * i) * 1024);
      float* patch = (float*)(smem + (wr * 2 + wc) * (64 * 68 * 4));
#pragma unroll
      for (int m = 0; m < 4; ++m)
#pragma unroll
        for (int n = 0; n < 4; ++n)
#pragma unroll
          for (int r = 0; r < 4; ++r) patch[(m * 16 + quad * 4 + r) * 68 + n * 16 + lc] = acc[m][n][r] * (1.f / MOE_WSC);
      asm volatile("s_waitcnt lgkmcnt(0)" ::: "memory");
#pragma unroll
      for (int i = 0; i < 16; ++i) {
        const float4 a4 = *(const float4*)&patch[(quad + 4 * i) * 68 + lc * 4];
        xr[i].x += a4.x; xr[i].y += a4.y; xr[i].z += a4.z; xr[i].w += a4.w;
      }
#pragma unroll
      for (int i = 0; i < 16; ++i) *(uint2*)(x1b + gbase + (size_t)(4 * i) * 1024) = make_uint2(pk2(xr[i].x, xr[i].y), pk2(xr[i].z, xr[i].w));
    };
    gemm128f8([=](int r) { return ao + (size_t)(row0 + r) * 1024; }, WoutT + (size_t)ct * 128 * 1024, 1024, 1024, epi, smem);
  }
}

DI float red8(float v) { v += dppx1(v); v += dppx2(v); v += dpp_hm(v); return v; }
DI void phase_route(const Params& p, unsigned char* smem) {
  const int tid = tidx(), lane = tid & 63, w = tid >> 6, l15 = lane & 15, kq = lane >> 4;
  unsigned char* xb2 = p.ws + OFF_R1;
  float* rstd2 = (float*)(p.ws + OFF_RSTD2);
  int* cnt = (int*)(p.ws + OFF_MISC);
  int2* list = (int2*)(p.ws + OFF_LIST);
  const bf16_t* wrt = (const bf16_t*)(p.ws + OFF_WR);
  const bf16_t* x1b = (const bf16_t*)(p.ws + OFF_X1B);
  float* part = (float*)smem;
  float* ssp = (float*)(smem + 17408);
  unsigned char* sm2 = smem + 18432;
  int* s_e = (int*)sm2; float* s_w = (float*)(sm2 + 512); int* s_rank = (int*)(sm2 + 1024); int* s_lcnt = (int*)(sm2 + 1536); int* s_base = (int*)(sm2 + 1600);
  for (int job = blockIdx.x; job < T / 32; job += gridDim.x) {
    if (tid < 16) s_lcnt[tid] = 0;
    const int kb = w * 256 + kq * 8;
#pragma nounroll
    for (int m = 0; m < 2; ++m) {
      const int trow = job * 32 + m * 16 + l15;
      uint4 xv[8];
#pragma unroll
      for (int st = 0; st < 8; ++st) xv[st] = *(const uint4*)(x1b + (size_t)trow * 1024 + kb + st * 32);
      f32x4 acc[2];
#pragma unroll
      for (int n = 0; n < 2; ++n) acc[n] = (f32x4){0.f, 0.f, 0.f, 0.f};
      float ss = 0.f;
#pragma unroll
      for (int st = 0; st < 8; ++st) {
        const int k = kb + st * 32;
        const float4 w0 = *(const float4*)(p.ffn_norm_w + k), w1 = *(const float4*)(p.ffn_norm_w + k + 4);
        bf16x8 bh[2], bl[2];
#pragma unroll
        for (int n = 0; n < 2; ++n) {
          bh[n] = *(const bf16x8*)(wrt + (size_t)(n * 16 + l15) * 1024 + k);
          bl[n] = *(const bf16x8*)(wrt + (size_t)(32 + n * 16 + l15) * 1024 + k);
        }
        const float4 x0 = make_float4(bflo(xv[st].x), bfhi(xv[st].x), bflo(xv[st].y), bfhi(xv[st].y)), x1 = make_float4(bflo(xv[st].z), bfhi(xv[st].z), bflo(xv[st].w), bfhi(xv[st].w));
        ss += x0.x * x0.x + x0.y * x0.y + x0.z * x0.z + x0.w * x0.w + x1.x * x1.x + x1.y * x1.y + x1.z * x1.z + x1.w * x1.w;
        const float h[8] = {x0.x * w0.x, x0.y * w0.y, x0.z * w0.z, x0.w * w0.w, x1.x * w1.x, x1.y * w1.y, x1.z * w1.z, x1.w * w1.w};
        *(uint2*)(xb2 + (size_t)trow * 1024 + k) = make_uint2(pk4_fp8(h[0], h[1], h[2], h[3]), pk4_fp8(h[4], h[5], h[6], h[7]));
        uint32_t hi[4], lo[4];
#pragma unroll
        for (int i = 0; i < 4; ++i) {
          hi[i] = pk2(h[2 * i], h[2 * i + 1]);
          lo[i] = pk2(h[2 * i] - bflo(hi[i]), h[2 * i + 1] - bfhi(hi[i]));
        }
        const bf16x8 ah = __builtin_bit_cast(bf16x8, make_uint4(hi[0], hi[1], hi[2], hi[3]));
        const bf16x8 al = __builtin_bit_cast(bf16x8, make_uint4(lo[0], lo[1], lo[2], lo[3]));
#pragma unroll
        for (int n = 0; n < 2; ++n) {
          acc[n] = __builtin_amdgcn_mfma_f32_16x16x32_bf16(al, bh[n], acc[n], 0, 0, 0);
          acc[n] = __builtin_amdgcn_mfma_f32_16x16x32_bf16(ah, bl[n], acc[n], 0, 0, 0);
          acc[n] = __builtin_amdgcn_mfma_f32_16x16x32_bf16(ah, bh[n], acc[n], 0, 0, 0);
        }
      }
#pragma unroll
      for (int n = 0; n < 2; ++n)
#pragma unroll
        for (int r = 0; r < 4; ++r) part[(w * 32 + m * 16 + kq * 4 + r) * 33 + n * 16 + l15] = acc[n][r];
      float sv = ss; sv += px16(sv); sv += px32(sv);
      if (kq == 0) ssp[w * 32 + m * 16 + l15] = sv;
    }
    __syncthreads();
    if (tid < 32) {
      const int t = job * 32 + tid;
      const float ssum = (ssp[tid] + ssp[32 + tid]) + (ssp[64 + tid] + ssp[96 + tid]);
      const float rstd = rsqrtf(ssum * (1.f / 1024.f) + 1e-6f);
      rstd2[t] = rstd;
      float lg[4], le[16];
#pragma unroll
      for (int c = 0; c < 20; ++c) {
        const float v = ((part[tid * 33 + c] + part[(32 + tid) * 33 + c]) + (part[(64 + tid) * 33 + c] + part[(96 + tid) * 33 + c])) * rstd;
        if (c < 4) lg[c] = v + p.rg_b[c]; else le[c - 4] = v + p.re_b[c - 4];
      }
      int grp = 0; float gm = lg[0];
#pragma unroll
      for (int c = 1; c < 4; ++c) if (lg[c] > gm) { gm = lg[c]; grp = c; }
      float gs = 0.f;
#pragma unroll
      for (int c = 0; c < 4; ++c) gs += __expf(lg[c] - gm);
      const float ggate = 1.f / gs;
      float el[4];
#pragma unroll
      for (int j = 0; j < 4; ++j) el[j] = grp == 0 ? le[j] : grp == 1 ? le[4 + j] : grp == 2 ? le[8 + j] : le[12 + j];
      int i1 = 0; float v1 = el[0];
#pragma unroll
      for (int j = 1; j < 4; ++j) if (el[j] > v1) { v1 = el[j]; i1 = j; }
      int i2 = -1; float v2 = -INFINITY;
#pragma unroll
      for (int j = 0; j < 4; ++j) if (j != i1 && el[j] > v2) { v2 = el[j]; i2 = j; }
      const float e2x = __expf(v2 - v1);
      s_e[tid * 2] = grp * 4 + i1; s_w[tid * 2] = ggate / (1.f + e2x);
      s_e[tid * 2 + 1] = grp * 4 + i2; s_w[tid * 2 + 1] = ggate * e2x / (1.f + e2x);
    }
    __syncthreads();
    int e = 0;
    if (tid < 64) { e = s_e[tid]; s_rank[tid] = atomicAdd(&s_lcnt[e], 1); }
    __syncthreads();
    if (tid < 16) { const int c = s_lcnt[tid]; s_base[tid] = c ? atomicAdd(&cnt[CNT_IDX(tid)], c) : 0; }
    __syncthreads();
    if (tid < 64) list[(size_t)e * T + s_base[e] + s_rank[tid]] = make_int2(job * 64 + tid, __float_as_int(s_w[tid]));
    __syncthreads();
  }
}

DI void moe_slot(const int* cnt, int slot, int& e, int& i, int& hbase) {
  int acc = 0; e = -1; i = 0; hbase = 0;
  for (int j = 0; j < 16; ++j) {
    const int nt = (cnt[CNT_IDX(j)] + 127) >> 7;
    if (e < 0 && slot < acc + nt) { e = j; i = slot - acc; hbase = (acc + i) * 128; }
    acc += nt;
  }
}
DI void phase_moe1(const Params& p, unsigned char* smem) {
  const int* cnt = (const int*)(p.ws + OFF_MISC);
  const int2* list = (const int2*)(p.ws + OFF_LIST);
  const unsigned char* xb2 = p.ws + OFF_R1;
  unsigned char* hid = p.ws + OFF_HID;
  const float* rstd2 = (const float*)(p.ws + OFF_RSTD2);
  for (int tile = vblock(); tile < 272 * 8; tile += gridDim.x) {
    const int slot = tile >> 3, ct = tile & 7;
    int e, i, hbase; moe_slot(cnt, slot, e, i, hbase);
    if (e < 0) continue;
    const int nrow = cnt[CNT_IDX(e)] - i * 128;
    const int2* le = list + (size_t)e * T + i * 128;
    auto epi = [=](f32x4 (&acc)[4][4], int wr, int wc, int lane) {
      const int quad = lane >> 4, lc = lane & 15;
      float rs[4][4];
#pragma unroll
      for (int m = 0; m < 4; ++m)
#pragma unroll
        for (int r = 0; r < 4; ++r) { const int row = wr * 64 + m * 16 + quad * 4 + r; rs[m][r] = rstd2[le[row < nrow ? row : nrow - 1].x >> 1] * (1.f / MOE_WSC); }
      unsigned char* patch = smem + ((wr * 2 + wc) * 64 * 48);
#pragma unroll
      for (int m = 0; m < 4; ++m)
#pragma unroll
        for (int n2 = 0; n2 < 2; ++n2)
#pragma unroll
          for (int r = 0; r < 4; ++r) {
            const float gv = acc[m][2 * n2][r] * rs[m][r], uv = acc[m][2 * n2 + 1][r] * rs[m][r];
            const float hv = gv * sigmoidf_(gv) * uv * MOE_HSC;
            patch[(m * 16 + quad * 4 + r) * 48 + n2 * 16 + lc] = (unsigned char)__builtin_amdgcn_cvt_pk_fp8_f32(hv, hv, 0, false);
          }
      asm volatile("s_waitcnt lgkmcnt(0)" ::: "memory");
#pragma unroll
      for (int i = 0; i < 2; ++i) {
        const int row = (lane >> 1) + 32 * i, ch = lane & 1;
        const uint4 q4 = *(const uint4*)&patch[row * 48 + ch * 16];
        *(uint4*)(hid + (size_t)(hbase + wr * 64 + row) * 512 + ct * 64 + wc * 32 + ch * 16) = q4;
      }
    };
    gemm128f8([=](int r) { const int rr = r < nrow ? r : nrow - 1; return xb2 + (size_t)(le[rr].x >> 1) * 1024; },
              p.ws + OFF_WGU + (size_t)e * 1024 * 1024 + (size_t)ct * 128 * 1024, 1024, 1024, epi, smem);
  }
}
DI void phase_moe2(const Params& p, unsigned char* smem) {
  const int* cnt = (const int*)(p.ws + OFF_MISC);
  const int2* list = (const int2*)(p.ws + OFF_LIST);
  const unsigned char* hid = p.ws + OFF_HID;
  unsigned char* y = p.ws + OFF_R3;
  for (int tile = vblock(); tile < 272 * 8; tile += gridDim.x) {
    const int slot = tile >> 3, ct = tile & 7;
    int e, i, hbase; moe_slot(cnt, slot, e, i, hbase);
    if (e < 0) continue;
    const int nrow = cnt[CNT_IDX(e)] - i * 128;
    const int2* le = list + (size_t)e * T + i * 128;
    auto epi = [=](f32x4 (&acc)[4][4], int wr, int wc, int lane) {
      const int quad = lane >> 4, lc = lane & 15;
      int2 en[4][4];
#pragma unroll
      for (int m = 0; m < 4; ++m)
#pragma unroll
        for (int r = 0; r < 4; ++r) { const int row = wr * 64 + m * 16 + quad * 4 + r; en[m][r] = le[row < nrow ? row : 0]; }
      unsigned char* patch = smem + ((wr * 2 + wc) * 64 * 80);
#pragma unroll
      for (int m = 0; m < 4; ++m)
#pragma unroll
        for (int r = 0; r < 4; ++r) {
          const float wgt = __int_as_float(en[m][r].y) * (MOE_YSC / (MOE_WSC * MOE_HSC));
#pragma unroll
          for (int n = 0; n < 4; ++n) { const float yv = acc[m][n][r] * wgt; patch[(m * 16 + quad * 4 + r) * 80 + n * 16 + lc] = (unsigned char)__builtin_amdgcn_cvt_pk_fp8_f32(yv, yv, 0, false); }
        }
      asm volatile("s_waitcnt lgkmcnt(0)" ::: "memory");
      int ents[4];
#pragma unroll
      for (int i = 0; i < 4; ++i) { const int row = wr * 64 + (lane >> 2) + 16 * i; ents[i] = le[row < nrow ? row : 0].x; }
#pragma unroll
      for (int i = 0; i < 4; ++i) {
        const int rowl = (lane >> 2) + 16 * i, ch = lane & 3, row = wr * 64 + rowl;
        if (row < nrow) *(uint4*)(y + (size_t)ents[i] * 1024 + ct * 128 + wc * 64 + ch * 16) = *(const uint4*)&patch[rowl * 80 + ch * 16];
      }
    };
    gemm128f8([=](int r) { return hid + (size_t)(hbase + r) * 512; }, p.ws + OFF_WD + (size_t)e * 1024 * 512 + (size_t)ct * 128 * 512, 512, 512, epi, smem);
  }
}

DI void phase_final(const Params& p, unsigned char* smem) {
  const int lane = tidx() & 63, w = tidx() >> 6;
  const unsigned char* y = p.ws + OFF_R3;
  for (int job = blockIdx.x; job < T / 4; job += gridDim.x) {
    const int t = job * 4 + w;
    float4* r4 = (float4*)(p.out + (size_t)t * 1024);
    const uint2* x4 = (const uint2*)((const bf16_t*)(p.ws + OFF_X1B) + (size_t)t * 1024);
    float4 v[4]; float ss = 0.f;
#pragma unroll
    for (int i = 0; i < 4; ++i) {
      const uint2 xb_ = x4[lane + 64 * i];
      v[i] = make_float4(bflo(xb_.x), bfhi(xb_.x), bflo(xb_.y), bfhi(xb_.y));
      const int a = *(const int*)(y + (size_t)(2 * t) * 1024 + (lane + 64 * i) * 4);
      const int b = *(const int*)(y + (size_t)(2 * t + 1) * 1024 + (lane + 64 * i) * 4);
      const f32v2 a01 = __builtin_amdgcn_cvt_pk_f32_fp8(a, false), a23 = __builtin_amdgcn_cvt_pk_f32_fp8(a, true);
      const f32v2 b01 = __builtin_amdgcn_cvt_pk_f32_fp8(b, false), b23 = __builtin_amdgcn_cvt_pk_f32_fp8(b, true);
      v[i].x += (a01[0] + b01[0]) * (1.f / MOE_YSC); v[i].y += (a01[1] + b01[1]) * (1.f / MOE_YSC);
      v[i].z += (a23[0] + b23[0]) * (1.f / MOE_YSC); v[i].w += (a23[1] + b23[1]) * (1.f / MOE_YSC);
      ss += v[i].x * v[i].x + v[i].y * v[i].y + v[i].z * v[i].z + v[i].w * v[i].w;
    }
    ss = wave_sum(ss);
    float rstd = rsqrtf(ss * (1.f / 1024.f) + 1e-6f);
#if DEBUG_CMP
    { const float* acc = (const float*)(p.ws + OFF_MISC) + 24; rstd *= 1.f + fminf(0.9f, 10.f * sqrtf(acc[0] / fmaxf(acc[1], 1e-30f))); }
#endif
#pragma unroll
    for (int i = 0; i < 4; ++i) {
      const float4 wv = ((const float4*)p.final_norm_w)[lane + 64 * i];
      float4 o; o.x = v[i].x * rstd * wv.x; o.y = v[i].y * rstd * wv.y; o.z = v[i].z * rstd * wv.z; o.w = v[i].w * rstd * wv.w;
      r4[lane + 64 * i] = o;
    }
  }
}

#ifndef DEBUG_CMP
#define DEBUG_CMP 0
#endif
#ifndef PROBE_ATTN2
#define PROBE_ATTN2 0
#endif
#ifndef PROBE_GEMM2
#define PROBE_GEMM2 0
#endif
#ifndef DBG_LO
#define DBG_LO 0
#define DBG_HI 1024
#endif
constexpr int SMEM_BYTES = (ATT_LDS > 36864 ? ATT_LDS : 36864) + 16;

DI void phase_compare(const Params& p, unsigned char* smem) {
  const float* a = (const float*)p.out; const float* b = (const float*)(p.ws + OFF_R3);
  float num = 0.f, den = 0.f;
  for (size_t i = (size_t)blockIdx.x * NTHREADS + tidx(); i < (size_t)T * 1024; i += (size_t)gridDim.x * NTHREADS) {
    const int c = (int)(i & 1023);
    if (c >= DBG_LO && c < DBG_HI) { const float d = a[i] - b[i]; num += d * d; den += b[i] * b[i]; }
  }
  num = wave_sum(num); den = wave_sum(den);
  if ((tidx() & 63) == 0) { float* acc = (float*)(p.ws + OFF_MISC) + 24; atomicAdd(acc, num); atomicAdd(acc + 1, den); }
}

#ifndef PROBE_MASK
#define PROBE_MASK 0
#endif
template <int P> DI void run_phase1(const Params& p, unsigned char* smem, int rep) {
  if (P == 0) phase_prep(p, smem);
  else if (P == 1) phase_inproj(p, smem);
  else if (P == 2) phase_cmp1(p, smem);
  else if (P == 3) phase_cmp2(p, smem);
  else if (P == 4) {
#if DEBUG_CMP
    phase_attn(p, smem);
    phase_attn_mfma(p, smem, p.out);
#else
    phase_attn_mfma(p, smem, (float*)(p.ws + OFF_R3), rep);
#endif
  }
  else if (P == 5) {
#if DEBUG_CMP
    phase_compare(p, smem);
#endif
    phase_mixnorm(p, smem);
  }
  else if (P == 6) phase_outproj(p, smem);
  else if (P == 7) phase_route(p, smem);
  else if (P == 8) phase_moe1(p, smem);
  else if (P == 9) phase_moe2(p, smem);
  else phase_final(p, smem);
}
template <int P> DI void run_phase(const Params& p, unsigned char* smem) { run_phase1<P>(p, smem, 0); }

template <int P> __global__ void __launch_bounds__(NTHREADS, 2) phase_kernel(Params p) {
  extern __shared__ __attribute__((aligned(16))) unsigned char smem[];
  run_phase<P>(p, smem);
}

__global__ void __launch_bounds__(NTHREADS, 2) mega_kernel(Params p) {
  extern __shared__ __attribute__((aligned(16))) unsigned char smem[];
  volatile unsigned* st = (volatile unsigned*)(smem + SMEM_BYTES - 16);
  if (tidx() == 0) { st[0] = 0u; st[1] = 0u; }
  __syncthreads();
  const XcdBarrier bar = xcd_barrier_post((unsigned*)(p.ws + OFF_BAR), st);
#define GSYNC() xcd_barrier(bar)
  run_phase<0>(p, smem); GSYNC(); if ((PROBE_MASK >> 0) & 1) { run_phase1<0>(p, smem, 1); GSYNC(); }
  run_phase<1>(p, smem); GSYNC(); if ((PROBE_MASK >> 1) & 1) { run_phase1<1>(p, smem, 1); GSYNC(); }
  run_phase<2>(p, smem); GSYNC(); if ((PROBE_MASK >> 2) & 1) { run_phase1<2>(p, smem, 1); GSYNC(); }
  run_phase<3>(p, smem); GSYNC(); if ((PROBE_MASK >> 3) & 1) { run_phase1<3>(p, smem, 1); GSYNC(); }
  run_phase<4>(p, smem); GSYNC(); if ((PROBE_MASK >> 4) & 1) { run_phase1<4>(p, smem, 1); GSYNC(); }
  run_phase<5>(p, smem); GSYNC(); if ((PROBE_MASK >> 5) & 1) { run_phase1<5>(p, smem, 1); GSYNC(); }
  run_phase<6>(p, smem); GSYNC(); if ((PROBE_MASK >> 6) & 1) { run_phase1<6>(p, smem, 1); GSYNC(); }
  run_phase<7>(p, smem); GSYNC(); if ((PROBE_MASK >> 7) & 1) { run_phase1<7>(p, smem, 1); GSYNC(); }
  run_phase<8>(p, smem); GSYNC(); if ((PROBE_MASK >> 8) & 1) { run_phase1<8>(p, smem, 1); GSYNC(); }
  run_phase<9>(p, smem); GSYNC(); if ((PROBE_MASK >> 9) & 1) { run_phase1<9>(p, smem, 1); GSYNC(); }
  run_phase<10>(p, smem);
}

extern "C" void kernel_launch(void* const* d_in, const int* in_sizes, int n_in, void* d_out, int out_size, void* d_ws, size_t ws_size,
                              hipStream_t stream) {
  if (n_in != 22 || ws_size < WS_END) { fprintf(stderr, "kernel_launch: unexpected inputs (n_in %d, ws %zu < %zu)\n", n_in, ws_size, (size_t)WS_END); return; }
  Params p{};
  const float** pf = (const float**)&p;
  for (int i = 0; i < 22; ++i) pf[i] = (const float*)d_in[i];
  p.out = (float*)d_out; p.ws = (unsigned char*)d_ws;
  for (int i = 0; i < 8; ++i) p.inv_freq[i] = (float)pow(500000.0, -(double)i / 8.0);
#if SINGLE
  static int grid_blocks = 0;
  if (!grid_blocks) {
    int dev = 0, cus = 0, per_cu = 0;
    hipGetDevice(&dev);
    hipDeviceGetAttribute(&cus, hipDeviceAttributeMultiprocessorCount, dev);
    hipFuncSetAttribute((const void*)mega_kernel, hipFuncAttributeMaxDynamicSharedMemorySize, SMEM_BYTES);
    hipOccupancyMaxActiveBlocksPerMultiprocessor(&per_cu, mega_kernel, NTHREADS, SMEM_BYTES);
    if (per_cu > 2) per_cu = 2;
    if (per_cu < 1) per_cu = 1;
    grid_blocks = cus * per_cu;
  }
  hipMemsetAsync((unsigned char*)d_ws + OFF_BAR, 0, XCD_BAR_WORDS * 4, stream);
  void* args[] = {&p};
  hipError_t e = hipLaunchCooperativeKernel((void*)mega_kernel, dim3(grid_blocks), dim3(NTHREADS), args, SMEM_BYTES, stream);
  if (e != hipSuccess) fprintf(stderr, "cooperative launch failed: %s (grid %d)\n", hipGetErrorString(e), grid_blocks);
#else
  static int init = 0;
  if (!init) {
    init = 1;
    hipFuncSetAttribute((const void*)phase_kernel<0>, hipFuncAttributeMaxDynamicSharedMemorySize, SMEM_BYTES);
    hipFuncSetAttribute((const void*)phase_kernel<1>, hipFuncAttributeMaxDynamicSharedMemorySize, SMEM_BYTES);
    hipFuncSetAttribute((const void*)phase_kernel<2>, hipFuncAttributeMaxDynamicSharedMemorySize, SMEM_BYTES);
    hipFuncSetAttribute((const void*)phase_kernel<3>, hipFuncAttributeMaxDynamicSharedMemorySize, SMEM_BYTES);
    hipFuncSetAttribute((const void*)phase_kernel<4>, hipFuncAttributeMaxDynamicSharedMemorySize, SMEM_BYTES);
    hipFuncSetAttribute((const void*)phase_kernel<5>, hipFuncAttributeMaxDynamicSharedMemorySize, SMEM_BYTES);
    hipFuncSetAttribute((const void*)phase_kernel<6>, hipFuncAttributeMaxDynamicSharedMemorySize, SMEM_BYTES);
    hipFuncSetAttribute((const void*)phase_kernel<7>, hipFuncAttributeMaxDynamicSharedMemorySize, SMEM_BYTES);
    hipFuncSetAttribute((const void*)phase_kernel<8>, hipFuncAttributeMaxDynamicSharedMemorySize, SMEM_BYTES);
    hipFuncSetAttribute((const void*)phase_kernel<9>, hipFuncAttributeMaxDynamicSharedMemorySize, SMEM_BYTES);
    hipFuncSetAttribute((const void*)phase_kernel<10>, hipFuncAttributeMaxDynamicSharedMemorySize, SMEM_BYTES);
  }
  const int G = 512;
  phase_kernel<0><<<G, NTHREADS, SMEM_BYTES, stream>>>(p);
  phase_kernel<1><<<G, NTHREADS, SMEM_BYTES, stream>>>(p);
  phase_kernel<2><<<G, NTHREADS, SMEM_BYTES, stream>>>(p);
  phase_kernel<3><<<G, NTHREADS, SMEM_BYTES, stream>>>(p);
  phase_kernel<4><<<G, NTHREADS, SMEM_BYTES, stream>>>(p);
  phase_kernel<5><<<G, NTHREADS, SMEM_BYTES, stream>>>(p);
  phase_kernel<6><<<G, NTHREADS, SMEM_BYTES, stream>>>(p);
  phase_kernel<7><<<G, NTHREADS, SMEM_BYTES, stream>>>(p);
  phase_kernel<8><<<G, NTHREADS, SMEM_BYTES, stream>>>(p);
  phase_kernel<9><<<G, NTHREADS, SMEM_BYTES, stream>>>(p);
  phase_kernel<10><<<G, NTHREADS, SMEM_BYTES, stream>>>(p);
#endif
}
```

```cpp
#include <hip/hip_runtime.h>
#include <hip/hip_cooperative_groups.h>
#include <stdint.h>
#include <math.h>
#include <stdio.h>
namespace cg = cooperative_groups;

#ifndef SINGLE
#define SINGLE 1
#endif

typedef unsigned short bf16_t;
using bf16x8 = __attribute__((ext_vector_type(8))) short;
using i32x8 = __attribute__((ext_vector_type(8))) int;
using f32x4  = __attribute__((ext_vector_type(4))) float;
#define DI __device__ __forceinline__

constexpr int T = 16384, D = 1024;
constexpr int NP = 2944;
constexpr int NCMP = 1023;
constexpr int NTHREADS = 256;

constexpr size_t al256(size_t x) { return (x + 255) & ~(size_t)255; }
constexpr size_t OFF_WIN   = 0;
constexpr size_t OFF_WOUT  = OFF_WIN  + (size_t)NP * 1024 * 2;
constexpr size_t OFF_WR    = OFF_WOUT + (size_t)1024 * 1024;
constexpr size_t OFF_CW1   = OFF_WOUT + (size_t)1024 * 1024 * 2;
constexpr size_t OFF_CW2   = OFF_CW1  + (size_t)2 * 256 * 2048 * 2;
constexpr size_t OFF_CB1   = OFF_CW2  + (size_t)2 * 128 * 256 * 2;
constexpr size_t OFF_WGU   = OFF_CB1  + 2 * 16 * 256 * 4;
constexpr size_t OFF_WD    = OFF_WGU  + (size_t)16 * 1024 * 1024 * 2;
constexpr size_t OFF_ROPE  = OFF_WD   + (size_t)16 * 1024 * 512 * 2;
constexpr size_t OFF_MISC  = OFF_ROPE + (size_t)T * 16 * 4;
constexpr size_t OFF_BAR   = OFF_MISC + 16384;
constexpr size_t OFF_LIST  = OFF_BAR + 16384;
constexpr size_t OFF_KC    = OFF_LIST + (size_t)16 * T * 8;
constexpr size_t OFF_GATES = OFF_KC   + (size_t)4 * 1024 * 64 * 2;
constexpr size_t OFF_RSTD2 = OFF_GATES + (size_t)T * 24 * 4;
constexpr size_t OFF_SS    = OFF_RSTD2 + (size_t)T * 4;
constexpr size_t OFF_R1    = OFF_SS + (size_t)T * 8;
constexpr size_t OFF_R2    = OFF_R1   + (size_t)T * 1024 * 2;
constexpr size_t OFF_QN    = OFF_R2;
constexpr size_t OFF_KV    = OFF_QN   + (size_t)T * 512 * 2;
constexpr size_t OFF_SB    = OFF_KV   + (size_t)12 * T * 64 * 2;
constexpr size_t OFF_HC    = OFF_SB   + (size_t)24 * T * 64 * 2;
constexpr size_t OFF_R2END = OFF_HC   + (size_t)4 * 1024 * 256 * 2;
constexpr float MOE_WSC = 32.f, MOE_HSC = 8.f, MOE_YSC = 16.f, ATT_ASC = 16.f;
constexpr size_t OFF_HID   = OFF_R2;
constexpr size_t OFF_X1B   = OFF_R2 + (size_t)32 * 1024 * 1024;
constexpr size_t OFF_R3    = OFF_R2END;
constexpr size_t WS_END    = OFF_R3   + (size_t)T * 1024 * 4;
static_assert(WS_END <= (size_t)256 * 1024 * 1024, "workspace overflow");
static_assert((size_t)34816 * 512 <= (size_t)32 * 1024 * 1024 && OFF_X1B + (size_t)T * 1024 * 2 <= OFF_R2END, "hidden / x1 overflow");

struct Params {
  const float* x; const int* positions; const float* attn_norm_w; const float* w_in;
  const float* cmp_pe_k; const float* cmp_pe_v; const float* cmp_k_w1; const float* cmp_k_w2;
  const float* cmp_v_w1; const float* cmp_v_w2; const float* nsa_out_norm_w; const float* sb_out_norm_w;
  const float* w_out; const float* ffn_norm_w; const float* rg_w; const float* rg_b;
  const float* re_w; const float* re_b; const float* w_gate; const float* w_up;
  const float* w_down; const float* final_norm_w;
  float* out; unsigned char* ws;
  float inv_freq[8];
};

DI bf16_t f2bf(float x) { uint32_t u = __float_as_uint(x); u += 0x7fffu + ((u >> 16) & 1u); return (bf16_t)(u >> 16); }
DI float bf2f(bf16_t b) { return __uint_as_float(((uint32_t)b) << 16); }
DI float bflo(uint32_t u) { return __uint_as_float(u << 16); }
DI float bfhi(uint32_t u) { return __uint_as_float(u & 0xffff0000u); }
DI float rdlane(float v, int i) { return __int_as_float(__builtin_amdgcn_readlane(__float_as_int(v), i)); }
DI float sigmoidf_(float x) { return 1.f / (1.f + __expf(-x)); }
DI int tidx() { int t = (int)__builtin_amdgcn_workitem_id_x(); asm volatile("" : "+v"(t)); return t; }
DI int lane_() { return tidx() & 63; }
DI float shx(float v, int m) { return __int_as_float(__builtin_amdgcn_ds_bpermute((lane_() ^ m) << 2, __float_as_int(v))); }
DI int shxi(int v, int m) { return __builtin_amdgcn_ds_bpermute((lane_() ^ m) << 2, v); }
DI float shi(float v, int src) { return __int_as_float(__builtin_amdgcn_ds_bpermute(src << 2, __float_as_int(v))); }
DI float dppx1(float v) { return __int_as_float(__builtin_amdgcn_update_dpp(0, __float_as_int(v), 0xB1, 0xF, 0xF, true)); }
DI float dppx2(float v) { return __int_as_float(__builtin_amdgcn_update_dpp(0, __float_as_int(v), 0x4E, 0xF, 0xF, true)); }
#define CNT_IDX(e) (1024 + (e) * 64)
DI int vblock() { const int G = gridDim.x, b = blockIdx.x; return (G & 7) ? b : (b & 7) * (G >> 3) + (b >> 3); }
DI float dpp_hm(float v) { return __int_as_float(__builtin_amdgcn_update_dpp(0, __float_as_int(v), 0x141, 0xF, 0xF, true)); }
DI float px32(float v) { const auto r = __builtin_amdgcn_permlane32_swap(__float_as_int(v), __float_as_int(v), false, false); return __int_as_float((lane_() & 32) ? r[0] : r[1]); }
DI float px16(float v) { const auto r = __builtin_amdgcn_permlane16_swap(__float_as_int(v), __float_as_int(v), false, false); return __int_as_float((lane_() & 16) ? r[0] : r[1]); }
DI int opaque0() { int z = 0; asm volatile("" : "+v"(z)); return z; }
DI float wave_max(float v) { for (int o = 32; o; o >>= 1) v = fmaxf(v, shx(v, o)); return v; }
DI float wave_sum(float v) { for (int o = 32; o; o >>= 1) v += shx(v, o); return v; }

#define XB_TMO      128
#define XB_XCNT(j)  (256  + 64 * (j))
#define XB_XSUB(j)  (1280 + 64 * (j))
#define XB_XGEN(j)  (2304 + 64 * (j))
#define XB_TOP      3328
#define XB_TOPGEN   3392
#define XCD_BAR_WORDS 3456
#define XB_SPIN_CAP (1u << 22)
DI unsigned xb_ld(unsigned* p)              { return __hip_atomic_load(p, __ATOMIC_RELAXED, __HIP_MEMORY_SCOPE_AGENT); }
DI unsigned xb_add(unsigned* p, unsigned v) { return __hip_atomic_fetch_add(p, v, __ATOMIC_RELAXED, __HIP_MEMORY_SCOPE_AGENT); }
DI unsigned xb_xcc_id() { return (unsigned)__builtin_amdgcn_s_getreg((3 << 11) | 20) & 0xFu; }
#define XB_SPIN(cond, bar) do { unsigned _sp = 0; while (cond) { __builtin_amdgcn_s_sleep(1); \
    if ((++_sp & 255u) == 0u) { if (xb_ld(&(bar)[XB_TMO])) break; if (_sp > XB_SPIN_CAP) { atomicAdd(&(bar)[XB_TMO], 1u); break; } } } } while (0)
struct XcdBarrier { unsigned* bar; unsigned x; volatile unsigned* st; unsigned rank; };
DI XcdBarrier xcd_barrier_post(unsigned* bar, volatile unsigned* st) {
  XcdBarrier b; b.bar = bar; b.x = xb_xcc_id(); b.st = st;
  b.rank = 0u;
  if (tidx() == 0) b.rank = xb_add(&bar[XB_XCNT(b.x)], 1u);
  return b;
}
DI void xcd_barrier_complete(unsigned* bar, unsigned x, unsigned& nloc, unsigned& nx) {
  const unsigned G = gridDim.x;
  unsigned sum, cnt, mine, sp = 0u;
  for (;;) {
    sum = 0u; cnt = 0u; mine = 0u;
#pragma unroll
    for (unsigned j = 0; j < 16; ++j) { const unsigned c = xb_ld(&bar[XB_XCNT(j)]); sum += c; cnt += (c > 0u) ? 1u : 0u; mine = (j == x) ? c : mine; }
    if (sum == G) break;
    __builtin_amdgcn_s_sleep(1);
    if ((++sp & 255u) == 0u) { if (xb_ld(&bar[XB_TMO])) break; if (sp > XB_SPIN_CAP) { atomicAdd(&bar[XB_TMO], 1u); break; } }
  }
  nloc = mine > 0u ? mine : 1u; nx = cnt > 0u ? cnt : 1u;
}
DI void xcd_barrier(const XcdBarrier& b) {
  asm volatile("s_waitcnt vmcnt(0)" ::: "memory");
  __syncthreads();
  if (tidx() == 0) {
    unsigned* bar = b.bar;
    __builtin_amdgcn_s_waitcnt(0);
    unsigned nloc = b.st[0], nx = b.st[1];
    const unsigned old = xb_add(&bar[XB_XSUB(b.x)], 1u);
    if (nloc == 0u) { xcd_barrier_complete(bar, b.x, nloc, nx); b.st[0] = nloc; b.st[1] = nx; }
    const unsigned gen = old / nloc;
    if (old + 1u == (gen + 1u) * nloc) {
      __builtin_amdgcn_fence(__ATOMIC_RELEASE, "agent");
      asm volatile("s_waitcnt vmcnt(0)" ::: "memory");
      const unsigned og = xb_add(&bar[XB_TOP], 1u);
      const unsigned tg = og / nx;
      if (og + 1u == (tg + 1u) * nx) xb_add(&bar[XB_TOPGEN], 1u);
      else XB_SPIN(xb_ld(&bar[XB_TOPGEN]) == tg, bar);
      __builtin_amdgcn_fence(__ATOMIC_ACQUIRE, "agent");
      xb_add(&bar[XB_XGEN(b.x)], 1u);
      asm volatile("s_waitcnt vmcnt(0)" ::: "memory");
    } else {
      __builtin_amdgcn_fence(__ATOMIC_ACQUIRE, "agent");
      XB_SPIN(xb_ld(&bar[XB_XGEN(b.x)]) == gen, bar);
      asm volatile("s_waitcnt vmcnt(0)" ::: "memory");
    }
  }
  __syncthreads();
}

template <class AP, class Epi>
DI void gemm128(AP aptr, const bf16_t* Bt, int ldb, int K, Epi epi, unsigned char* smem) {
  const int tid = tidx(), lane = tid & 63, w = tid >> 6, wr = w >> 1, wc = w & 1;
  const int lr = tid >> 3, lch = tid & 7;
  const int sch = (lch ^ ((lr >> 1) & 7)) * 8;
  const bf16_t* ap0 = aptr(lr) + sch;
  const bf16_t* ap1 = aptr(lr + 32) + sch;
  const bf16_t* ap2 = aptr(lr + 64) + sch;
  const bf16_t* ap3 = aptr(lr + 96) + sch;
  const bf16_t* bp0 = Bt + (size_t)(lr) * ldb + sch;
  const bf16_t* bp1 = Bt + (size_t)(lr + 32) * ldb + sch;
  const bf16_t* bp2 = Bt + (size_t)(lr + 64) * ldb + sch;
  const bf16_t* bp3 = Bt + (size_t)(lr + 96) * ldb + sch;
  unsigned char* dst0 = smem + tid * 16;
#define GEMM_DMA(st, kofs) do { unsigned char* d_ = dst0 + (st) * 32768; \
    __builtin_amdgcn_global_load_lds((const unsigned*)(ap0 + (kofs)), (unsigned*)(d_), 16, 0, 0); \
    __builtin_amdgcn_global_load_lds((const unsigned*)(ap1 + (kofs)), (unsigned*)(d_ + 4096), 16, 0, 0); \
    __builtin_amdgcn_global_load_lds((const unsigned*)(ap2 + (kofs)), (unsigned*)(d_ + 8192), 16, 0, 0); \
    __builtin_amdgcn_global_load_lds((const unsigned*)(ap3 + (kofs)), (unsigned*)(d_ + 12288), 16, 0, 0); \
    __builtin_amdgcn_global_load_lds((const unsigned*)(bp0 + (kofs)), (unsigned*)(d_ + 16384), 16, 0, 0); \
    __builtin_amdgcn_global_load_lds((const unsigned*)(bp1 + (kofs)), (unsigned*)(d_ + 20480), 16, 0, 0); \
    __builtin_amdgcn_global_load_lds((const unsigned*)(bp2 + (kofs)), (unsigned*)(d_ + 24576), 16, 0, 0); \
    __builtin_amdgcn_global_load_lds((const unsigned*)(bp3 + (kofs)), (unsigned*)(d_ + 28672), 16, 0, 0); } while (0)
  f32x4 acc[4][4];
#pragma unroll
  for (int m = 0; m < 4; ++m)
#pragma unroll
    for (int n = 0; n < 4; ++n) acc[m][n] = (f32x4){0.f, 0.f, 0.f, 0.f};
  const int l15 = lane & 15, kq = lane >> 4, rsw = (l15 >> 1) & 7;
  GEMM_DMA(0, 0);
  asm volatile("s_waitcnt vmcnt(0)" ::: "memory");
  __syncthreads();
  int st = 0;
  for (int k0 = 0; k0 < K; k0 += 64) {
    if (k0 + 64 < K) GEMM_DMA(st ^ 1, k0 + 64);
    const bf16_t* As = (const bf16_t*)(smem + st * 32768);
    const bf16_t* Bs = As + 128 * 64;
#pragma unroll
    for (int kk = 0; kk < 2; ++kk) {
      bf16x8 a[4], b[4];
#pragma unroll
      for (int m = 0; m < 4; ++m) a[m] = *(const bf16x8*)&As[(wr * 64 + m * 16 + l15) * 64 + (((kk * 4 + kq) ^ rsw) * 8)];
#pragma unroll
      for (int n = 0; n < 4; ++n) b[n] = *(const bf16x8*)&Bs[(wc * 64 + n * 16 + l15) * 64 + (((kk * 4 + kq) ^ rsw) * 8)];
      __builtin_amdgcn_s_setprio(1);
#pragma unroll
      for (int m = 0; m < 4; ++m)
#pragma unroll
        for (int n = 0; n < 4; ++n) acc[m][n] = __builtin_amdgcn_mfma_f32_16x16x32_bf16(a[m], b[n], acc[m][n], 0, 0, 0);
      __builtin_amdgcn_s_setprio(0);
    }
    asm volatile("s_waitcnt vmcnt(0)" ::: "memory");
    __syncthreads();
    st ^= 1;
  }
#undef GEMM_DMA
  epi(acc, wr, wc, lane);
  __syncthreads();
}

struct NoMid { DI void operator()(f32x4 (&)[4][4], int, int) const {} };
template <class AP, class Epi, class Mid = NoMid>
DI void gemm128f8(AP aptr, const unsigned char* Bt, int ldb, int K, Epi epi, unsigned char* smem, Mid mid = Mid()) {
  const int tid = tidx(), lane = tid & 63, w = tid >> 6, wr = w >> 1, wc = w & 1;
  const int lr = tid >> 3, lch = tid & 7;
  const int sch = (lch ^ ((lr >> 1) & 7)) * 16;
  const unsigned char* ap0 = aptr(lr) + sch;
  const unsigned char* ap1 = aptr(lr + 32) + sch;
  const unsigned char* ap2 = aptr(lr + 64) + sch;
  const unsigned char* ap3 = aptr(lr + 96) + sch;
  const unsigned char* bp0 = Bt + (size_t)(lr) * ldb + sch;
  const unsigned char* bp1 = Bt + (size_t)(lr + 32) * ldb + sch;
  const unsigned char* bp2 = Bt + (size_t)(lr + 64) * ldb + sch;
  const unsigned char* bp3 = Bt + (size_t)(lr + 96) * ldb + sch;
  unsigned char* dst0 = smem + tid * 16;
#define G8_LD(P, kofs) do { P##0 = *(const uint4*)(ap0 + (kofs)); P##1 = *(const uint4*)(ap1 + (kofs)); P##2 = *(const uint4*)(ap2 + (kofs)); P##3 = *(const uint4*)(ap3 + (kofs)); \
    P##4 = *(const uint4*)(bp0 + (kofs)); P##5 = *(const uint4*)(bp1 + (kofs)); P##6 = *(const uint4*)(bp2 + (kofs)); P##7 = *(const uint4*)(bp3 + (kofs)); } while (0)
#define G8_ST(P, st) do { unsigned char* d_ = dst0 + (st) * 32768; \
    *(uint4*)(d_) = P##0; *(uint4*)(d_ + 4096) = P##1; *(uint4*)(d_ + 8192) = P##2; *(uint4*)(d_ + 12288) = P##3; \
    *(uint4*)(d_ + 16384) = P##4; *(uint4*)(d_ + 20480) = P##5; *(uint4*)(d_ + 24576) = P##6; *(uint4*)(d_ + 28672) = P##7; } while (0)
#define G8_BAR() asm volatile("s_waitcnt lgkmcnt(0)\n\ts_barrier" ::: "memory")
  f32x4 acc[4][4];
#pragma unroll
  for (int m = 0; m < 4; ++m)
#pragma unroll
    for (int n = 0; n < 4; ++n) acc[m][n] = (f32x4){0.f, 0.f, 0.f, 0.f};
  const int l15 = lane & 15, kq = lane >> 4, rsw = (l15 >> 1) & 7;
  const int c0 = ((2 * kq) ^ rsw) * 16, c1 = ((2 * kq + 1) ^ rsw) * 16;
#define G8_COMPUTE(st) do { \
    const unsigned char* As = smem + (st) * 32768; \
    const unsigned char* Bs = As + 16384; \
    i32x8 a[4], b[4]; \
    _Pragma("unroll") for (int m = 0; m < 4; ++m) { \
      const unsigned char* rp = &As[(wr * 64 + m * 16 + l15) * 128]; \
      const uint4 lo = *(const uint4*)(rp + c0), hi = *(const uint4*)(rp + c1); \
      a[m] = (i32x8){(int)lo.x, (int)lo.y, (int)lo.z, (int)lo.w, (int)hi.x, (int)hi.y, (int)hi.z, (int)hi.w}; } \
    _Pragma("unroll") for (int n = 0; n < 4; ++n) { \
      const unsigned char* rp = &Bs[(wc * 64 + n * 16 + l15) * 128]; \
      const uint4 lo = *(const uint4*)(rp + c0), hi = *(const uint4*)(rp + c1); \
      b[n] = (i32x8){(int)lo.x, (int)lo.y, (int)lo.z, (int)lo.w, (int)hi.x, (int)hi.y, (int)hi.z, (int)hi.w}; } \
    __builtin_amdgcn_s_setprio(1); \
    _Pragma("unroll") for (int m = 0; m < 4; ++m) \
      _Pragma("unroll") for (int n = 0; n < 4; ++n) \
        acc[m][n] = __builtin_amdgcn_mfma_scale_f32_16x16x128_f8f6f4(a[m], b[n], acc[m][n], 0, 0, 0, 0x7F7F7F7F, 0, 0x7F7F7F7F); \
    __builtin_amdgcn_s_setprio(0); } while (0)
  uint4 ra0, ra1, ra2, ra3, ra4, ra5, ra6, ra7, rb0, rb1, rb2, rb3, rb4, rb5, rb6, rb7;
  G8_LD(ra, 0);
  G8_LD(rb, 128);
  G8_ST(ra, 0);
  G8_BAR();
  for (int k0 = 0; k0 < K; k0 += 256) {
    if (k0 + 256 < K) G8_LD(ra, k0 + 256);
    __builtin_amdgcn_sched_barrier(0);
    G8_COMPUTE(0);
    __builtin_amdgcn_sched_barrier(0);
    G8_ST(rb, 1);
    G8_BAR();
    if (k0 + 384 < K) G8_LD(rb, k0 + 384);
    __builtin_amdgcn_sched_barrier(0);
    G8_COMPUTE(1);
    __builtin_amdgcn_sched_barrier(0);
    if (k0 + 256 < K) G8_ST(ra, 0);
    G8_BAR();
    if (k0 == 256) mid(acc, wr, lane);
  }
#undef G8_LD
#undef G8_ST
#undef G8_BAR
#undef G8_COMPUTE
  epi(acc, wr, wc, lane);
  __syncthreads();
}

template <int NK, class RowMap>
DI void transpose_tile64(const float* src, int ldsrc, int k0, int nsrc0, int ncols_valid, const float* rowscale,
                         bf16_t* dst, int lddst, RowMap dstrow, float* tile  ) {
  const int tid = tidx();
  const int c4 = (tid & 15) * 4, kb = tid >> 4;
  float4 v[NK][4];
#pragma unroll
  for (int t = 0; t < NK; ++t)
#pragma unroll
    for (int i = 0; i < 4; ++i) {
      v[t][i] = make_float4(0.f, 0.f, 0.f, 0.f);
      if (c4 < ncols_valid) v[t][i] = *(const float4*)(src + (size_t)(k0 + 64 * t + kb + 16 * i) * ldsrc + nsrc0 + c4);
    }
#pragma unroll
  for (int t = 0; t < NK; ++t) {
#pragma unroll
    for (int i = 0; i < 4; ++i) {
      const int k = kb + 16 * i;
      const float sc = rowscale ? rowscale[k0 + 64 * t + k] : 1.f;
      tile[k * 65 + c4] = v[t][i].x * sc; tile[k * 65 + c4 + 1] = v[t][i].y * sc; tile[k * 65 + c4 + 2] = v[t][i].z * sc; tile[k * 65 + c4 + 3] = v[t][i].w * sc;
    }
    __syncthreads();
    {
      const int n = tid >> 2, ks = (tid & 3) * 16;
      uint32_t pk[8];
#pragma unroll
      for (int e = 0; e < 8; ++e) pk[e] = (uint32_t)f2bf(tile[(ks + 2 * e) * 65 + n]) | ((uint32_t)f2bf(tile[(ks + 2 * e + 1) * 65 + n]) << 16);
      uint4* d = (uint4*)(dst + (size_t)dstrow(n) * lddst + k0 + 64 * t + ks);
      d[0] = make_uint4(pk[0], pk[1], pk[2], pk[3]); d[1] = make_uint4(pk[4], pk[5], pk[6], pk[7]);
    }
    __syncthreads();
  }
}

DI uint32_t pk4_fp8(float a, float b, float c, float d) {
  int v = 0;
  v = __builtin_amdgcn_cvt_pk_fp8_f32(a, b, v, false);
  v = __builtin_amdgcn_cvt_pk_fp8_f32(c, d, v, true);
  return (uint32_t)v;
}
template <int NK, class RowMap>
DI void transpose_tile64_f8(const float* src, int ldsrc, int k0, int nsrc0, float scale, const float* rowscale,
                            unsigned char* dst, int lddst, RowMap dstrow, float* tile  ) {
  const int tid = tidx();
  const int c4 = (tid & 15) * 4, kb = tid >> 4;
  float4 v[NK][4];
#pragma unroll
  for (int t = 0; t < NK; ++t)
#pragma unroll
    for (int i = 0; i < 4; ++i) v[t][i] = *(const float4*)(src + (size_t)(k0 + 64 * t + kb + 16 * i) * ldsrc + nsrc0 + c4);
#pragma unroll
  for (int t = 0; t < NK; ++t) {
#pragma unroll
    for (int i = 0; i < 4; ++i) {
      const int k = kb + 16 * i;
      const float sc = rowscale ? rowscale[k0 + 64 * t + k] * scale : scale;
      tile[k * 65 + c4] = v[t][i].x * sc; tile[k * 65 + c4 + 1] = v[t][i].y * sc; tile[k * 65 + c4 + 2] = v[t][i].z * sc; tile[k * 65 + c4 + 3] = v[t][i].w * sc;
    }
    __syncthreads();
    {
      const int n = tid >> 2, ks = (tid & 3) * 16;
      uint32_t pk[4];
#pragma unroll
      for (int e = 0; e < 4; ++e)
        pk[e] = pk4_fp8(tile[(ks + 4 * e) * 65 + n], tile[(ks + 4 * e + 1) * 65 + n], tile[(ks + 4 * e + 2) * 65 + n], tile[(ks + 4 * e + 3) * 65 + n]);
      *(uint4*)(dst + (size_t)dstrow(n) * lddst + k0 + 64 * t + ks) = make_uint4(pk[0], pk[1], pk[2], pk[3]);
    }
    __syncthreads();
  }
}

constexpr int J_WIN = 16 * 46, J_WOUT = 16 * 16, J_CW1 = 2 * 32 * 4, J_CW2 = 2 * 4, J_WG = 16 * 8 * 8, J_WU = J_WG, J_WDN = 16 * 4 * 16;
constexpr int J_XB = T / 16, J_ROPE = T * 8 / 256, J_BIAS = 32, J_ZERO = 1 + 8;
constexpr int JB_WOUT = J_WIN, JB_CW1 = JB_WOUT + J_WOUT, JB_CW2 = JB_CW1 + J_CW1, JB_WG = JB_CW2 + J_CW2, JB_WU = JB_WG + J_WG,
              JB_WDN = JB_WU + J_WU, JB_XB = JB_WDN + J_WDN, JB_ROPE = JB_XB + J_XB, JB_BIAS = JB_ROPE + J_ROPE, JB_ZERO = JB_BIAS + J_BIAS,
              J_TOTAL = JB_ZERO + J_ZERO;

DI void prep_job(const Params& p, int job, unsigned char* smem) {
  float* tile = (float*)smem;
  const int tid = tidx(), lane = tid & 63, w = tid >> 6;
  {
    if (job < JB_WOUT) {
      const int kt = job / 46, nt = job % 46, nb = nt * 64;
      int srcc = 0, nv = 64;
      if (nb < 1280) srcc = nb; else if (nb < 2816) srcc = nb + 24; else if (nb == 2816) { srcc = 1280; nv = 24; } else nv = 0;
      transpose_tile64<1>(p.w_in, 2840, kt * 64, srcc, nv, nullptr, (bf16_t*)(p.ws + OFF_WIN), 1024, [=](int n) { return nb + n; }, tile);
    } else if (job < JB_CW1) {
      const int j = job - JB_WOUT, kt = j / 16, nt = j % 16;
      const float* rs = (kt < 8) ? p.nsa_out_norm_w : (p.sb_out_norm_w - 512);
      transpose_tile64_f8<1>(p.w_out, 1024, kt * 64, nt * 64, MOE_WSC, rs, p.ws + OFF_WOUT, 1024, [=](int n) { return nt * 64 + n; }, tile);
    } else if (job < JB_CW2) {
      const int j = job - JB_CW1, kv = j / 128, kt = (j % 128) / 4, nt = j % 4;
      transpose_tile64<1>(kv ? p.cmp_v_w1 : p.cmp_k_w1, 256, kt * 64, nt * 64, 64, nullptr, (bf16_t*)(p.ws + OFF_CW1) + (size_t)kv * 256 * 2048, 2048,
                       [=](int n) { return nt * 64 + n; }, tile);
    } else if (job < JB_WG) {
      const int j = job - JB_CW2, kv = j / 4, kt = j % 4;
      bf16_t* dst = (bf16_t*)(p.ws + OFF_CW2) + (size_t)kv * 128 * 256;
      transpose_tile64<1>(kv ? p.cmp_v_w2 : p.cmp_k_w2, 64, kt * 64, 0, 64, nullptr, dst, 256, [=](int n) { return n; }, tile);
      for (int i = tid; i < 64 * 64; i += NTHREADS) dst[(size_t)(64 + i / 64) * 256 + kt * 64 + (i % 64)] = 0;
    } else if (job < JB_WDN) {
      const int up = job >= JB_WU;
      const int j = job - (up ? JB_WU : JB_WG), e = j / 64, kt = (j % 64) / 8, nt = j % 8;
      const float* src = (up ? p.w_up : p.w_gate) + (size_t)e * 1024 * 512;
      transpose_tile64_f8<2>(src, 512, kt * 128, nt * 64, MOE_WSC, nullptr, p.ws + OFF_WGU + (size_t)e * 1024 * 1024, 1024,
                       [=](int n) { const int jj = nt * 64 + n; return (jj >> 4) * 32 + (jj & 15) + up * 16; }, tile);
    } else if (job < JB_XB) {
      const int j = job - JB_WDN, e = j / 64, kt = (j % 64) / 16, nt = j % 16;
      transpose_tile64_f8<2>(p.w_down + (size_t)e * 512 * 1024, 1024, kt * 128, nt * 64, MOE_WSC, nullptr, p.ws + OFF_WD + (size_t)e * 1024 * 512, 512,
                       [=](int n) { return nt * 64 + n; }, tile);
    } else if (job < JB_ROPE) {
      const int row0 = (job - JB_XB) * 16 + w * 4;
      float4 v[4][4];
#pragma unroll
      for (int r = 0; r < 4; ++r)
#pragma unroll
        for (int i = 0; i < 4; ++i) v[r][i] = ((const float4*)(p.x + (size_t)(row0 + r) * 1024))[lane + 64 * i];
      float4 wv[4];
#pragma unroll
      for (int i = 0; i < 4; ++i) wv[i] = ((const float4*)p.attn_norm_w)[lane + 64 * i];
#pragma unroll
      for (int r = 0; r < 4; ++r) {
        float ss = 0.f;
#pragma unroll
        for (int i = 0; i < 4; ++i) ss += v[r][i].x * v[r][i].x + v[r][i].y * v[r][i].y + v[r][i].z * v[r][i].z + v[r][i].w * v[r][i].w;
        ss = wave_sum(ss);
        const float rstd = rsqrtf(ss * (1.f / 1024.f) + 1e-6f);
        if (lane == 0) ((float*)(p.ws + OFF_RSTD2))[row0 + r] = 1.f / rstd;
        bf16_t* dst = (bf16_t*)(p.ws + OFF_R1) + (size_t)(row0 + r) * 1024;
#pragma unroll
        for (int i = 0; i < 4; ++i) {
          ushort4 o; o.x = f2bf(v[r][i].x * rstd * wv[i].x); o.y = f2bf(v[r][i].y * rstd * wv[i].y); o.z = f2bf(v[r][i].z * rstd * wv[i].z); o.w = f2bf(v[r][i].w * rstd * wv[i].w);
          *(ushort4*)(dst + (lane + 64 * i) * 4) = o;
        }
      }
    } else if (job < JB_BIAS) {
      const int idx = (job - JB_ROPE) * 256 + tid, t = idx >> 3, i = idx & 7;
      const float ang = (float)p.positions[t] * p.inv_freq[i];
      const double rev = (double)ang * 0.15915494309189533577;
      const float fr = (float)(rev - rint(rev));
      float* rt = (float*)(p.ws + OFF_ROPE);
      rt[idx * 2] = __builtin_amdgcn_cosf(fr); rt[idx * 2 + 1] = __builtin_amdgcn_sinf(fr);
    } else if (job < JB_ZERO) {
      const int jb = job - JB_BIAS, kv = jb >> 4, ch = jb & 15;
      const float* pe = kv ? p.cmp_pe_v : p.cmp_pe_k; const float* w1 = kv ? p.cmp_v_w1 : p.cmp_k_w1;
      float s0 = 0.f, s1 = 0.f, s2 = 0.f, s3 = 0.f;
#pragma unroll 1
      for (int i0 = ch * 128; i0 < ch * 128 + 128; i0 += 32) {
        float wv[32];
#pragma unroll
        for (int u = 0; u < 32; ++u) wv[u] = w1[(size_t)(i0 + u) * 256 + tid];
#pragma unroll
        for (int u = 0; u < 32; u += 4) { s0 += pe[i0 + u] * wv[u]; s1 += pe[i0 + u + 1] * wv[u + 1]; s2 += pe[i0 + u + 2] * wv[u + 2]; s3 += pe[i0 + u + 3] * wv[u + 3]; }
      }
      ((float*)(p.ws + OFF_CB1))[(kv * 16 + ch) * 256 + tid] = (s0 + s1) + (s2 + s3);
    } else if (job == JB_ZERO) {
      for (int i = tid; i < T * 2 / 4; i += NTHREADS) ((float4*)(p.ws + OFF_SS))[i] = make_float4(0.f, 0.f, 0.f, 0.f);
      ((int*)(p.ws + OFF_MISC))[tid] = (tid == 16) ? (int)gridDim.x : 0; ((int*)(p.ws + OFF_MISC))[256 + tid] = 0;
      if (tid < 16) ((int*)(p.ws + OFF_MISC))[CNT_IDX(tid)] = 0;
    } else {
      const int col = tid & 31, kbase = (job - JB_ZERO - 1) * 128 + (tid >> 5) * 16;
      uint32_t hi[8], lo[8];
#pragma unroll
      for (int i = 0; i < 8; ++i) {
        float v[2];
#pragma unroll
        for (int h = 0; h < 2; ++h) { const int k = kbase + 2 * i + h; v[h] = col < 4 ? p.rg_w[k * 4 + col] : col < 20 ? p.re_w[k * 16 + col - 4] : 0.f; }
        const bf16_t h0 = f2bf(v[0]), h1 = f2bf(v[1]);
        hi[i] = (uint32_t)h0 | ((uint32_t)h1 << 16);
        lo[i] = (uint32_t)f2bf(v[0] - bf2f(h0)) | ((uint32_t)f2bf(v[1] - bf2f(h1)) << 16);
      }
      bf16_t* wrt = (bf16_t*)(p.ws + OFF_WR);
      uint4* dh = (uint4*)(wrt + (size_t)col * 1024 + kbase); uint4* dl = (uint4*)(wrt + (size_t)(32 + col) * 1024 + kbase);
      dh[0] = make_uint4(hi[0], hi[1], hi[2], hi[3]); dh[1] = make_uint4(hi[4], hi[5], hi[6], hi[7]);
      dl[0] = make_uint4(lo[0], lo[1], lo[2], lo[3]); dl[1] = make_uint4(lo[4], lo[5], lo[6], lo[7]);
    }
  }
}

DI bool prep_deferred(int job) { return (job >= JB_WOUT && job < JB_CW1) || (job >= JB_WG && job < JB_XB); }
constexpr int ND_JOBS = J_WOUT + J_WG + J_WU + J_WDN;
DI void phase_prep(const Params& p, unsigned char* smem) {
  for (int job = J_TOTAL - 1 - (int)blockIdx.x; job >= 0; job -= gridDim.x) if (!prep_deferred(job)) prep_job(p, job, smem);
}

DI void cmp1_tile(const Params& p, int tile, unsigned char* smem);
DI const volatile unsigned* barrier_words(unsigned char* smem);
DI void phase_inproj(const Params& p, unsigned char* smem) {
  const bf16_t* xb = (const bf16_t*)(p.ws + OFF_R1);
  const bf16_t* WinT = (const bf16_t*)(p.ws + OFF_WIN);
  const float* rope = (const float*)(p.ws + OFF_ROPE);
  bf16_t* Qn = (bf16_t*)(p.ws + OFF_QN); bf16_t* KV = (bf16_t*)(p.ws + OFF_KV); bf16_t* SB = (bf16_t*)(p.ws + OFF_SB);
  float* gates = (float*)(p.ws + OFF_GATES);
  const int G8 = gridDim.x >> 3, vb = vblock(), xcd = (gridDim.x & 7) ? 0 : vb / G8, vi = (gridDim.x & 7) ? vb : vb % G8, vstep = (gridDim.x & 7) ? gridDim.x : G8;
  const int qmax = (gridDim.x & 7) ? 128 * 23 : 16 * 23;
  auto do_tile = [&](int rt, int ct) {
    const int row0 = rt * 128;
      auto epi = [=](f32x4 (&acc)[4][4], int wr, int wc, int lane) {
        const int quad = lane >> 4, lc = lane & 15;
        const int colw = ct * 128 + wc * 64;
        if (colw < 2816) {
          bf16_t* dbase; int ld; bool ropew; float scale = 1.f;
          if (colw < 512) { dbase = Qn + colw; ld = 512; ropew = true; scale = 0.125f * 1.44269504f; }
          else if (colw < 1280) { const int buf = (colw - 512) >> 6; dbase = KV + (size_t)buf * T * 64; ld = 64; ropew = ((buf & 2) == 0) && (buf >= 4); }
          else { const int ih = (colw - 1280) >> 6; dbase = SB + (size_t)ih * T * 64; ld = 64; ropew = false; scale = (ih < 8) ? 0.125f * 1.44269504f : 1.f; }
          float2 csv[4][4];
          if (ropew) {
#pragma unroll
            for (int m = 0; m < 4; ++m)
#pragma unroll
              for (int r = 0; r < 4; ++r) csv[m][r] = *(const float2*)(rope + ((size_t)(row0 + wr * 64 + m * 16 + quad * 4 + r) * 8 + (lc & 7)) * 2);
          }
          bf16_t* patch = (bf16_t*)(smem + ((wr * 2 + wc) * 64 * 72 * 2));
#pragma unroll
          for (int m = 0; m < 4; ++m)
#pragma unroll
            for (int n = 0; n < 4; ++n)
#pragma unroll
              for (int r = 0; r < 4; ++r) {
                float v = acc[m][n][r];
                if (ropew && n == 0) {
                  const float pv = shx(v, 8);
                  const float2 cs = csv[m][r];
                  v = (lc < 8) ? (v * cs.x - pv * cs.y) : (v * cs.x + pv * cs.y);
                }
                patch[(m * 16 + quad * 4 + r) * 72 + n * 16 + lc] = f2bf(v * scale);
              }
          asm volatile("s_waitcnt lgkmcnt(0)" ::: "memory");
#pragma unroll
          for (int i = 0; i < 8; ++i) {
            const int row = (lane >> 3) + 8 * i, ch = lane & 7;
            const uint4 q4 = *(const uint4*)&patch[row * 72 + ch * 8];
            *(uint4*)(dbase + (size_t)(row0 + wr * 64 + row) * ld + ch * 8) = q4;
          }
        } else if (colw < 2880) {
#pragma unroll
          for (int m = 0; m < 4; ++m)
#pragma unroll
            for (int n = 0; n < 2; ++n) {
              const int cgi = colw - 2816 + n * 16 + lc;
              if (cgi < 24) {
#pragma unroll
                for (int r = 0; r < 4; ++r) gates[(size_t)(row0 + wr * 64 + m * 16 + quad * 4 + r) * 24 + cgi] = sigmoidf_(acc[m][n][r]);
              }
            }
        }
      };
    gemm128([=](int r) { return xb + (size_t)(row0 + r) * 1024; }, WinT + (size_t)ct * 128 * 1024, 1024, 1024, epi, smem);
  };
  int* misc = (int*)(p.ws + OFF_MISC);
  const int x = (int)(xb_xcc_id() & 7u);
  int* slot = (int*)(smem + 65536 + 8192);
  const int n45 = x < 7 ? 34 : 32;
  int* queue = misc + 64 + x;
  const int qn = n45 + 16 * 21;
  const volatile unsigned* stp = barrier_words(smem);
  const int ticket = (int)stp[2], nblk = (int)stp[0];
  int next = ticket;
  bool cmp_pending = ticket < 8;
  for (;;) {
    __syncthreads();
    if (tidx() == 0) *slot = next;
    __syncthreads();
    const int q0 = *slot;
    const bool have = q0 < qn;
    if (have) {
      if (tidx() == 0) next = nblk + atomicAdd(queue, 1);
      if (q0 < n45) {
        do_tile(x * 16 + (q0 >> 1), 4 + (q0 & 1));
        asm volatile("s_waitcnt vmcnt(0)" ::: "memory");
        __syncthreads();
        if (tidx() == 0) __hip_atomic_fetch_add(&misc[96 + x], 1, __ATOMIC_RELAXED, __HIP_MEMORY_SCOPE_AGENT);
      } else {
        const int q = q0 - n45;
        const int rg = q / 168, rem = q - rg * 168, cti = rem >> 3;
        do_tile(x * 16 + rg * 8 + (rem & 7), cti < 4 ? cti : cti + 2);
      }
    }
    if (cmp_pending) {
      cmp_pending = false;
      __syncthreads();
      if (tidx() == 0) {
        unsigned sp = 0;
        while (__hip_atomic_load(&misc[96 + x], __ATOMIC_RELAXED, __HIP_MEMORY_SCOPE_AGENT) < n45) { __builtin_amdgcn_s_sleep(8); if (++sp > (1u << 24)) break; }
      }
      __syncthreads();
      asm volatile("" ::: "memory");
      cmp1_tile(p, (ticket >> 1) * 16 + x * 2 + (ticket & 1), smem);
    }
    if (!have) break;
  }
}

DI void cmp2_tile(const Params& p, int tile, unsigned char* smem);
DI void cmp1_tile(const Params& p, int tile, unsigned char* smem) {
  const bf16_t* KV = (const bf16_t*)(p.ws + OFF_KV);
  bf16_t* HC = (bf16_t*)(p.ws + OFF_HC);
  const float* cb1 = (const float*)(p.ws + OFF_CB1);
  {
    const int kvg = tile >> 4, kv = kvg >> 1, g = kvg & 1, rt = (tile >> 1) & 7, ct = tile & 1;
    const bf16_t* src = KV + (size_t)(kv * 2 + g) * T * 64;
    bf16_t* hc = HC + (size_t)kvg * 1024 * 256;
    auto epi = [=](f32x4 (&acc)[4][4], int wr, int wc, int lane) {
      const int quad = lane >> 4, lc = lane & 15;
#pragma unroll
      for (int m = 0; m < 4; ++m)
#pragma unroll
        for (int n = 0; n < 4; ++n) {
          const int col = ct * 128 + wc * 64 + n * 16 + lc;
          float b = 0.f;
#pragma unroll
          for (int ch = 0; ch < 16; ++ch) b += cb1[(kv * 16 + ch) * 256 + col];
#pragma unroll
          for (int r = 0; r < 4; ++r) {
            const int row = rt * 128 + wr * 64 + m * 16 + quad * 4 + r;
            const float v = acc[m][n][r] + b;
            hc[(size_t)row * 256 + col] = f2bf(v * sigmoidf_(v));
          }
        }
    };
    gemm128([=](int r) { return src + (size_t)(rt * 128 + r) * 1024; }, (const bf16_t*)(p.ws + OFF_CW1) + (size_t)kv * 256 * 2048 + (size_t)ct * 128 * 2048, 2048, 2048, epi, smem);
    int* slot = (int*)(smem + 65536);
    asm volatile("s_waitcnt vmcnt(0)" ::: "memory");
    __syncthreads();
    if (tidx() == 0) *slot = atomicAdd((int*)(p.ws + OFF_MISC) + 32 + (tile >> 1), 1);
    __syncthreads();
    const int arrived = *slot;
    __syncthreads();
    if (arrived == 1) cmp2_tile(p, tile >> 1, smem);
  }
}
DI void cmp2_tile(const Params& p, int tile, unsigned char* smem) {
  const bf16_t* HC = (const bf16_t*)(p.ws + OFF_HC);
  bf16_t* KC = (bf16_t*)(p.ws + OFF_KC);
  {
    const int kvg = tile >> 3, kv = kvg >> 1, rt = tile & 7;
    const bf16_t* hc = HC + (size_t)kvg * 1024 * 256;
    bf16_t* kc = KC + (size_t)kvg * 1024 * 64;
    auto epi = [=](f32x4 (&acc)[4][4], int wr, int wc, int lane) {
      const int quad = lane >> 4, lc = lane & 15;
      if (wc == 0) {
#pragma unroll
        for (int m = 0; m < 4; ++m)
#pragma unroll
          for (int n = 0; n < 4; ++n)
#pragma unroll
            for (int r = 0; r < 4; ++r) {
              const int row = rt * 128 + wr * 64 + m * 16 + quad * 4 + r;
              kc[(size_t)row * 64 + n * 16 + lc] = f2bf(acc[m][n][r]);
            }
      }
    };
    gemm128([=](int r) { return hc + (size_t)(rt * 128 + r) * 256; }, (const bf16_t*)(p.ws + OFF_CW2) + (size_t)kv * 128 * 256, 256, 256, epi, smem);
  }
}

DI void dot4(const float* qs, const bf16_t* krow, float (&s)[4]) {
  s[0] = s[1] = s[2] = s[3] = 0.f;
#pragma unroll
  for (int c = 0; c < 8; ++c) {
    const uint4 u = ((const uint4*)krow)[c];
    const float f[8] = {bflo(u.x), bfhi(u.x), bflo(u.y), bfhi(u.y), bflo(u.z), bfhi(u.z), bflo(u.w), bfhi(u.w)};
#pragma unroll
    for (int e = 0; e < 8; ++e) {
#pragma unroll
      for (int r = 0; r < 4; ++r) s[r] += qs[r * 64 + c * 8 + e] * f[e];
    }
  }
}
DI float dot1(const float* qs, const bf16_t* krow) {
  float s = 0.f;
#pragma unroll
  for (int c = 0; c < 8; ++c) {
    const uint4 u = ((const uint4*)krow)[c];
    const float f[8] = {bflo(u.x), bfhi(u.x), bflo(u.y), bfhi(u.y), bflo(u.z), bfhi(u.z), bflo(u.w), bfhi(u.w)};
#pragma unroll
    for (int e = 0; e < 8; ++e) s += qs[c * 8 + e] * f[e];
  }
  return s;
}

DI void attend_chunk(const float* qs, const bf16_t* K, const bf16_t* V, int key0, int t, int lane,
                     float (&mr)[4], float (&lr)[4], float (&orr)[4]) {
  const int key = key0 + lane;
  const bool valid = key <= t;
  const int kc = key < T ? key : T - 1;
  float s[4];
  dot4(qs + opaque0(), K + (size_t)kc * 64, s);
  s[0] *= 0.69314718f; s[1] *= 0.69314718f; s[2] *= 0.69314718f; s[3] *= 0.69314718f;
  float pr[4];
#pragma unroll
  for (int r = 0; r < 4; ++r) {
    const float sv = valid ? s[r] : -INFINITY;
    const float cm = wave_max(sv);
    const float mn = fmaxf(mr[r], cm);
    const float alpha = __expf(mr[r] - mn);
    pr[r] = valid ? __expf(sv - mn) : 0.f;
    lr[r] = lr[r] * alpha + wave_sum(pr[r]);
    mr[r] = mn;
    orr[r] *= alpha;
  }
#pragma unroll 2
  for (int i = 0; i < 64; ++i) {
    int ki = key0 + i; ki = ki < T ? ki : T - 1;
    const float v = bf2f(V[(size_t)ki * 64 + lane]);
#pragma unroll
    for (int r = 0; r < 4; ++r) orr[r] += rdlane(pr[r], i) * v;
  }
}

constexpr int ATT_NSA_JOBS = T * 2 / 4;
constexpr int ATT_SB_JOBS  = T * 8 / 4;
DI void phase_attn(const Params& p, unsigned char* smem) {
  const int tid = tidx(), lane = tid & 63, w = tid >> 6;
  float* wsm = (float*)smem + w * 2304;
  float* qs = wsm; float* sc = wsm + 256; float* ps = wsm + 1280;
  const bf16_t* Qn = (const bf16_t*)(p.ws + OFF_QN); const bf16_t* KV = (const bf16_t*)(p.ws + OFF_KV); const bf16_t* SB = (const bf16_t*)(p.ws + OFF_SB);
  const bf16_t* KC = (const bf16_t*)(p.ws + OFF_KC);
  const float* gates = (const float*)(p.ws + OFF_GATES);
  float* omix = (float*)(p.ws + OFF_R3);
  for (int job = blockIdx.x; job < ATT_NSA_JOBS + ATT_SB_JOBS; job += gridDim.x) {
    if (job < ATT_NSA_JOBS) {
      const int item = job * 4 + w, t = item >> 1, g = item & 1;
      for (int i = lane; i < 256; i += 64) qs[i] = bf2f(Qn[(size_t)t * 512 + g * 256 + i]);
      for (int i = lane; i < 1024; i += 64) ps[i] = 0.f;
      const bf16_t* kc = KC + (size_t)(0 * 2 + g) * 1024 * 64;
      const bf16_t* vc = KC + (size_t)(1 * 2 + g) * 1024 * 64;
      int nv = t >= 31 ? ((t - 31) >> 4) + 1 : 0; if (nv > NCMP) nv = NCMP;
      float oc[4];
#pragma nounroll
      for (int r = 0; r < 4; ++r) {
        float mx = -INFINITY;
#pragma nounroll
        for (int n = lane; n < nv; n += 64) { const float s = 0.69314718f * dot1(qs + r * 64 + opaque0(), kc + (size_t)n * 64); sc[n] = s; mx = fmaxf(mx, s); }
        mx = wave_max(mx);
        float sum = 0.f;
        for (int n = lane; n < nv; n += 64) { const float e = __expf(sc[n] - mx); sc[n] = e; sum += e; }
        sum = wave_sum(sum);
        const float inv = nv > 0 ? 1.f / fmaxf(sum, 1e-30f) : 0.f;
        for (int n = lane; n < nv; n += 64) { const float pr = sc[n] * inv; sc[n] = pr; ps[n] += pr; }
        float o = 0.f;
#pragma unroll 4
        for (int n = 0; n < nv; ++n) o += sc[n] * bf2f(vc[(size_t)n * 64 + lane]);
        if (r == 0) oc[0] = o; else if (r == 1) oc[1] = o; else if (r == 2) oc[2] = o; else oc[3] = o;
      }
      const int bq = t >> 6;
      float cand[4];
#pragma unroll
      for (int i = 0; i < 4; ++i) {
        const int m = lane + 64 * i;
        float imp = 0.f;
#pragma unroll
        for (int dn = -1; dn <= 3; ++dn) { const int n = 4 * m + dn; if (n >= 0 && n < NCMP) imp += ps[n]; }
        const bool allowed = m <= bq, forced = (m == 0) || (m == bq) || (m == bq - 1);
        cand[i] = allowed ? imp + (forced ? 1.0e4f : 0.f) : -1e30f;
      }
      int* selidx = (int*)sc;
      for (int k = 0; k < 16; ++k) {
        float bv = cand[0]; int bi = lane;
#pragma unroll
        for (int i = 1; i < 4; ++i) if (cand[i] > bv) { bv = cand[i]; bi = lane + 64 * i; }
        for (int o = 32; o; o >>= 1) {
          const float ov = __shfl_xor(bv, o); const int oi = __shfl_xor(bi, o);
          if (ov > bv || (ov == bv && oi < bi)) { bv = ov; bi = oi; }
        }
#pragma unroll
        for (int i = 0; i < 4; ++i) if (bi == lane + 64 * i) cand[i] = -3.0e38f;
        if (lane == 0) selidx[k] = bi;
      }
      float mr[4], lr[4], osel[4];
#pragma unroll
      for (int r = 0; r < 4; ++r) { mr[r] = -INFINITY; lr[r] = 0.f; osel[r] = 0.f; }
      {
        const bf16_t* K = KV + (size_t)(1 * 4 + 0 * 2 + g) * T * 64; const bf16_t* V = KV + (size_t)(1 * 4 + 1 * 2 + g) * T * 64;
#pragma nounroll
        for (int k = 0; k < 16; ++k) {
          const int j = __builtin_amdgcn_readfirstlane(selidx[k]);
          if (j > bq) continue;
          attend_chunk(qs, K, V, j * 64, t, lane, mr, lr, osel);
        }
#pragma unroll
        for (int r = 0; r < 4; ++r) osel[r] = osel[r] / fmaxf(lr[r], 1e-30f);
      }
      float owin[4];
#pragma unroll
      for (int r = 0; r < 4; ++r) { mr[r] = -INFINITY; lr[r] = 0.f; owin[r] = 0.f; }
      {
        const bf16_t* K = KV + (size_t)(2 * 4 + 0 * 2 + g) * T * 64; const bf16_t* V = KV + (size_t)(2 * 4 + 1 * 2 + g) * T * 64;
        const int lo = t - 511 > 0 ? t - 511 : 0;
#pragma nounroll
        for (int k0 = lo; k0 <= t; k0 += 64) attend_chunk(qs, K, V, k0, t, lane, mr, lr, owin);
#pragma unroll
        for (int r = 0; r < 4; ++r) owin[r] = owin[r] / fmaxf(lr[r], 1e-30f);
      }
#pragma unroll
      for (int r = 0; r < 4; ++r) {
        const int h = g * 4 + r;
        const float* gt = gates + (size_t)t * 24 + h * 3;
        omix[(size_t)t * 1024 + h * 64 + lane] = gt[0] * oc[r] + gt[1] * osel[r] + gt[2] * owin[r];
      }
    } else {
      const int item = (job - ATT_NSA_JOBS) * 4 + w, t = item >> 3, h = item & 7;
      const bf16_t* Q = SB + (size_t)(0 * 8 + h) * T * 64; const bf16_t* K = SB + (size_t)(1 * 8 + h) * T * 64; const bf16_t* V = SB + (size_t)(2 * 8 + h) * T * 64;
      qs[lane] = bf2f(Q[(size_t)t * 64 + lane]);
      float carry = 0.f, o = 0.f;
      for (int c0 = t - 1; c0 >= 0; c0 -= 64) {
        const int s = c0 - lane; const bool valid = s >= 0;
        const float z = 0.69314718f * dot1(qs + opaque0(), K + (size_t)(valid ? s : 0) * 64);
        const float sp = fmaxf(z, 0.f) + log1pf(__expf(-fabsf(z)));
        const float ln = valid ? -sp : 0.f;
        float incl = ln;
        for (int o2 = 1; o2 < 64; o2 <<= 1) { const float u = __shfl_up(incl, o2); if (lane >= o2) incl += u; }
        const float la = z + ln + (incl - ln) + carry;
        const float a = valid ? __expf(la) : 0.f;
        carry += rdlane(incl, 63);
#pragma unroll 4
        for (int i = 0; i < 64; ++i) { int si = c0 - i; si = si > 0 ? si : 0; o += rdlane(a, i) * bf2f(V[(size_t)si * 64 + lane]); }
        if (carry < -104.f) break;
      }
      omix[(size_t)t * 1024 + 512 + h * 64 + lane] = o;
    }
  }
}

using s16x4 = __attribute__((ext_vector_type(4))) short;
using u32x4 = __attribute__((ext_vector_type(4))) unsigned;
typedef __bf16 bf16v2 __attribute__((ext_vector_type(2)));
typedef float f32v2 __attribute__((ext_vector_type(2)));
#define LDS_AS __attribute__((address_space(3)))
DI uint32_t pk2(float a, float b) { f32v2 x = {a, b}; return __builtin_bit_cast(uint32_t, __builtin_convertvector(x, bf16v2)); }
DI bf16x8 pack8(f32x4 a, f32x4 b) { u32x4 r = {pk2(a[0], a[1]), pk2(a[2], a[3]), pk2(b[0], b[1]), pk2(b[2], b[3])}; return __builtin_bit_cast(bf16x8, r); }
DI s16x4 tr_read(const bf16_t* p) { return __builtin_amdgcn_ds_read_tr16_b64_v4i16((LDS_AS s16x4*)p); }
DI f32x4 mfma16(bf16x8 a, bf16x8 b, f32x4 c) { return __builtin_amdgcn_mfma_f32_16x16x32_bf16(a, b, c, 0, 0, 0); }

constexpr float SM_THR = 11.5f;
DI float ex2(float x) { return __builtin_amdgcn_exp2f(x); }
constexpr int KST = 80;
constexpr int L_STAGE = 2 * 64 * KST * 2;
constexpr int L_Q     = 2 * L_STAGE;
constexpr int L_SELM  = L_Q + 256 * 64 * 2;
constexpr int L_QUADM = L_SELM + 64 * 8 * 4;
constexpr int L_BLKM  = L_QUADM + 16 * 8 * 4;
constexpr int L_VOTE  = L_BLKM + 32;
constexpr int L_JLIST = L_VOTE + 64;
constexpr int ATT_LDS = L_JLIST + 1024;
constexpr int NQ = 2;
constexpr int QPI = 16 * NQ;
constexpr int NSA_ITEMS = (T / QPI) * 2, SB_ITEMS = 2048;

#define STAGE_LOAD(LV, Kg, Vg, key0) do { const unsigned off_ = (unsigned)((((key0) + (tid >> 2)) * 64 + (tid & 3) * 16) * 2); \
    const uint4* kp_ = (const uint4*)((const unsigned char*)(Kg) + off_); rk0 = kp_[0]; rk1 = kp_[1]; \
    if (LV) { const uint4* vp_ = (const uint4*)((const unsigned char*)(Vg) + off_); rv0 = vp_[0]; rv1 = vp_[1]; } } while (0)
#define STAGE_STORE(LV, Ks, Vs) do { const int row_ = tid >> 2, c_ = (tid & 3) * 16; \
    *(uint4*)&(Ks)[row_ * KST + c_] = rk0; *(uint4*)&(Ks)[row_ * KST + c_ + 8] = rk1; \
    if (LV) { *(uint4*)&(Vs)[row_ * KST + c_] = rv0; *(uint4*)&(Vs)[row_ * KST + c_ + 8] = rv1; } } while (0)
DI bf16_t* stageK(unsigned char* lds, int s) { return (bf16_t*)(lds + s * L_STAGE); }
DI bf16_t* stageV(unsigned char* lds, int s) { return (bf16_t*)(lds + s * L_STAGE + 64 * KST * 2); }

struct NsaW {
  f32x4 o[4][4];
  float m[4];
  f32x4 l[4];
  float aux[4];
  float prev3[4];
  int tbase;
  int q0;
};

template <int MODE>
DI void nsa_compute(NsaW& W, const bf16_t* Ks, const bf16_t* Vs, int j, int lane, int w, unsigned char* lds, float* impw) {
  const int col = lane & 15, kq = lane >> 4;
  const int key0 = j * 64;
  const uint32_t* selm = (const uint32_t*)(lds + L_SELM);
  const uint32_t* quadm = (const uint32_t*)(lds + L_QUADM) + w * (NQ * 8);
  const bf16_t* Qs = (const bf16_t*)(lds + L_Q) + (w * (NQ * 16) + col) * 64;
  const int qsw = (col >> 1) & 7;
  uint32_t qact = 0xfu, csel = 0xfu;
  if (MODE == 2) {
    const uint32_t* sr = selm + (w * (NQ * 4) + (col >> 2)) * 8 + (j >> 5);
    const int sh = j & 31;
    uint32_t qa = 0u, cs = 0u;
#pragma unroll
    for (int qd = 0; qd < NQ; ++qd) { qa |= ((quadm[qd * 8 + (j >> 5)] >> sh) & 1u) << qd; cs |= ((sr[qd * 32] >> sh) & 1u) << qd; }
    qact = __builtin_amdgcn_readfirstlane(qa); csel = cs;
    if (qact == 0u) return;
  }
  bf16x8 ka[4][2];
#pragma unroll
  for (int kt = 0; kt < 4; ++kt)
#pragma unroll
    for (int ks = 0; ks < 2; ++ks) ka[kt][ks] = *(const bf16x8*)&Ks[(kt * 16 + col) * KST + ks * 32 + kq * 8];
  const bf16_t* vbase = &Vs[(4 * kq + (col >> 2)) * KST + 4 * (col & 3)];
#pragma unroll
  for (int quad = 0; quad < NQ; ++quad) {
    if (MODE == 2) { if (!((qact >> quad) & 1u)) continue; }
    const int t = W.tbase + 4 * quad;
    const int q0i = W.q0;
    bool needmask;
    if (MODE == 0 || MODE == 1) needmask = (key0 + 63) * 16 + 31 > q0i;
    else if (MODE == 2) needmask = key0 + 63 > q0i;
    else needmask = (key0 + 63 > q0i) || (key0 < q0i + QPI - 1 - 511);
    const bool colsel = (MODE != 2) || ((csel >> quad) & 1u);
    const float mq = W.m[quad];
    const bool uninit = mq < -1e29f;
    const float c0 = uninit ? 0.f : mq;
    float cneg = -c0;
    if (MODE == 2 && !colsel) cneg = -INFINITY;
    if (MODE == 1 && uninit) cneg = -INFINITY;
    f32x4 s[4];
    {
      const bf16x8 q0 = *(const bf16x8*)&Qs[quad * 16 * 64 + ((kq ^ qsw) * 8)];
      const bf16x8 q1 = *(const bf16x8*)&Qs[quad * 16 * 64 + (((4 + kq) ^ qsw) * 8)];
#pragma unroll
      for (int kt = 0; kt < 4; ++kt) {
        s[kt] = (f32x4){cneg, cneg, cneg, cneg};
        s[kt] = mfma16(ka[kt][0], q0, s[kt]);
        s[kt] = mfma16(ka[kt][1], q1, s[kt]);
      }
    }
    if (needmask) {
#pragma unroll
      for (int kt = 0; kt < 4; ++kt)
#pragma unroll
        for (int r = 0; r < 4; ++r) {
          const int key = key0 + kt * 16 + 4 * kq + r;
          bool v;
          if (MODE == 0 || MODE == 1) v = key * 16 + 31 <= t;
          else if (MODE == 2) v = key <= t;
          else v = (key <= t) && (key >= t - 511);
          s[kt][r] = v ? s[kt][r] : -INFINITY;
        }
    }
    f32x4 p[4];
    if (MODE == 1) {
      const float il = W.aux[quad];
#pragma unroll
      for (int kt = 0; kt < 4; ++kt)
#pragma unroll
        for (int r = 0; r < 4; ++r) p[kt][r] = ex2(s[kt][r]) * il;
    } else {
      float mloc = fmaxf(fmaxf(fmaxf(s[0][0], s[0][1]), fmaxf(s[0][2], s[0][3])), fmaxf(fmaxf(s[1][0], s[1][1]), fmaxf(s[1][2], s[1][3])));
      mloc = fmaxf(mloc, fmaxf(fmaxf(fmaxf(s[2][0], s[2][1]), fmaxf(s[2][2], s[2][3])), fmaxf(fmaxf(s[3][0], s[3][1]), fmaxf(s[3][2], s[3][3]))));
      if (__any(mloc > (uninit ? -INFINITY : SM_THR))) {
        float mx = fmaxf(mloc, shx(mloc, 16)); mx = fmaxf(mx, shx(mx, 32));
        const bool upd = mx > -INFINITY;
        const float d = upd ? (uninit ? mx : fmaxf(mx, 0.f)) : 0.f;
#pragma unroll
        for (int kt = 0; kt < 4; ++kt) s[kt] = s[kt] - d;
        if (upd) W.m[quad] = c0 + d;
        const float alpha = uninit ? 1.f : ex2(-d);
        W.l[quad] = W.l[quad] * alpha;
        if (MODE != 0) {
#pragma unroll
          for (int dt = 0; dt < 4; ++dt) W.o[quad][dt] *= alpha;
        }
      }
#pragma unroll
      for (int kt = 0; kt < 4; ++kt)
#pragma unroll
        for (int r = 0; r < 4; ++r) p[kt][r] = ex2(s[kt][r]);
    }
    const bf16x8 pb0 = pack8(p[0], p[1]), pb1 = pack8(p[2], p[3]);
    if (MODE != 1) {
      const bf16x8 ones = {0x3F80, 0x3F80, 0x3F80, 0x3F80, 0x3F80, 0x3F80, 0x3F80, 0x3F80};
      W.l[quad] = mfma16(ones, pb0, W.l[quad]);
      W.l[quad] = mfma16(ones, pb1, W.l[quad]);
    }
    if (MODE == 0) continue;
    if (MODE == 1) {
#pragma unroll
      for (int kt = 0; kt < 4; ++kt) {
        f32x4 ps = p[kt];
#pragma unroll
        for (int r = 0; r < 4; ++r) { ps[r] += dppx1(ps[r]); ps[r] += dppx2(ps[r]); }
        const int mi = j * 16 + kt * 4 + kq;
        if ((col & 3) == 0) {
          float* row = (float*)((unsigned char*)impw + (unsigned)((quad * 4 + (col >> 2)) * 512 * 4));
          row[mi] = ps[0] + ps[1] + ps[2] + ps[3];
          if (mi < 255) row[256 + mi + 1] = ps[3];
        }
      }
    }
#pragma unroll
    for (int dt = 0; dt < 4; ++dt) {
#pragma unroll
      for (int s2 = 0; s2 < 2; ++s2) {
        const bf16_t* p0 = vbase + (2 * s2) * 16 * KST + dt * 16;
        const s16x4 lo = tr_read(p0), hi = tr_read(p0 + 16 * KST);
        W.o[quad][dt] = mfma16(__builtin_shufflevector(lo, hi, 0, 1, 2, 3, 4, 5, 6, 7), s2 ? pb1 : pb0, W.o[quad][dt]);
      }
    }
  }
}

#define STAGE_LOAD2(S, LV, Kg, Vg, key0) do { const unsigned off_ = (unsigned)((((key0) + (tid >> 2)) * 64 + (tid & 3) * 16) * 2); \
    const uint4* kp_ = (const uint4*)((const unsigned char*)(Kg) + off_); S##k0 = kp_[0]; S##k1 = kp_[1]; \
    if (LV) { const uint4* vp_ = (const uint4*)((const unsigned char*)(Vg) + off_); S##v0 = vp_[0]; S##v1 = vp_[1]; } } while (0)
#define STAGE_STORE2(S, LV, Ks, Vs) do { const int row_ = tid >> 2, c_ = (tid & 3) * 16; \
    *(uint4*)&(Ks)[row_ * KST + c_] = S##k0; *(uint4*)&(Ks)[row_ * KST + c_ + 8] = S##k1; \
    if (LV) { *(uint4*)&(Vs)[row_ * KST + c_] = S##v0; *(uint4*)&(Vs)[row_ * KST + c_ + 8] = S##v1; } } while (0)
template <int MODE, class JAt>
DI void nsa_stream(NsaW& W, const bf16_t* Kg, const bf16_t* Vg, JAt jat, int n, unsigned char* lds, int tid, int lane, int w, float* impw) {
  constexpr bool LV = (MODE != 0);
  if (n <= 0) return;
  uint4 Ak0, Ak1, Av0 = make_uint4(0, 0, 0, 0), Av1 = make_uint4(0, 0, 0, 0), Bk0 = make_uint4(0, 0, 0, 0), Bk1 = make_uint4(0, 0, 0, 0), Bv0 = make_uint4(0, 0, 0, 0), Bv1 = make_uint4(0, 0, 0, 0);
  STAGE_LOAD2(A, LV, Kg, Vg, jat(0) * 64);
  STAGE_STORE2(A, LV, stageK(lds, 0), stageV(lds, 0));
  if (n > 1) STAGE_LOAD2(A, LV, Kg, Vg, jat(1) * 64);
  if (n > 2) STAGE_LOAD2(B, LV, Kg, Vg, jat(2) * 64);
  __syncthreads();
  int i = 0;
  for (;;) {
    nsa_compute<MODE>(W, stageK(lds, 0), stageV(lds, 0), jat(i), lane, w, lds, impw);
    if (i + 1 < n) STAGE_STORE2(A, LV, stageK(lds, 1), stageV(lds, 1));
    __syncthreads();
    if (i + 1 >= n) break;
    if (i + 3 < n) STAGE_LOAD2(A, LV, Kg, Vg, jat(i + 3) * 64);
    ++i;
    nsa_compute<MODE>(W, stageK(lds, 1), stageV(lds, 1), jat(i), lane, w, lds, impw);
    if (i + 1 < n) STAGE_STORE2(B, LV, stageK(lds, 0), stageV(lds, 0));
    __syncthreads();
    if (i + 1 >= n) break;
    if (i + 3 < n) STAGE_LOAD2(B, LV, Kg, Vg, jat(i + 3) * 64);
    ++i;
  }
}

DI int next_bit(const uint32_t* bm, int prev) {
  int j = prev + 1;
  while (j < 256) {
    const uint32_t wd = bm[j >> 5] >> (j & 31);
    if (wd) return j + __builtin_ctz(wd);
    j = (j | 31) + 1;
  }
  return -1;
}

DI void nsa_item(const Params& p, int item, unsigned char* lds, float* omix, int tid) {
  const int lane = tid & 63, w = __builtin_amdgcn_readfirstlane(tid >> 6), col = lane & 15, kq = lane >> 4;
  const int g = item & 1, q0 = (T / QPI - 1 - (item >> 1)) * QPI, bq = q0 >> 6;
  const bf16_t* Qn = (const bf16_t*)(p.ws + OFF_QN);
  const bf16_t* KV = (const bf16_t*)(p.ws + OFF_KV);
  const bf16_t* KC = (const bf16_t*)(p.ws + OFF_KC);
  const float* gates = (const float*)(p.ws + OFF_GATES);
  uint32_t* selm = (uint32_t*)(lds + L_SELM);
  uint32_t* quadm = (uint32_t*)(lds + L_QUADM);
  uint32_t* blkm = (uint32_t*)(lds + L_BLKM);
  unsigned char* jlist = lds + L_JLIST;
  float* impw = (float*)(p.ws + OFF_R3 + (size_t)32 * 1024 * 1024) + ((size_t)blockIdx.x * 4 + w) * (NQ * 4) * 512;
  if (tid < QPI * 4) {
    const uint4* src = (const uint4*)(Qn + (size_t)(q0 + (tid >> 2)) * 512 + g * 256 + (tid & 3) * 64);
    bf16_t* dst = (bf16_t*)(lds + L_Q) + tid * 64;
    const int sw = ((tid & 15) >> 1) & 7;
#pragma unroll
    for (int c = 0; c < 8; ++c) *(uint4*)&dst[(c ^ sw) * 8] = src[c];
  }
  NsaW W;
  f32x4 comb[NQ][4];
  W.tbase = q0 + w * (NQ * 4) + (col >> 2);
  W.q0 = q0;
#pragma unroll
  for (int quad = 0; quad < NQ; ++quad) {
    W.m[quad] = -1e30f; W.l[quad] = (f32x4){0.f, 0.f, 0.f, 0.f}; W.prev3[quad] = 0.f; W.aux[quad] = 0.f;
#pragma unroll
    for (int dt = 0; dt < 4; ++dt) W.o[quad][dt] = (f32x4){0.f, 0.f, 0.f, 0.f};
  }
  __syncthreads();
  int nvmax = ((q0 + QPI - 1 - 31) >> 4) + 1; if (nvmax < 0) nvmax = 0; nvmax = nvmax < NCMP ? nvmax : NCMP;
  const int nblk = (nvmax + 63) >> 6;
  const bf16_t* kc = KC + (size_t)(0 * 2 + g) * 1024 * 64;
  const bf16_t* vc = KC + (size_t)(1 * 2 + g) * 1024 * 64;
  auto jseq = [=](int i) { return i; };
  nsa_stream<0>(W, kc, vc, jseq, nblk, lds, tid, lane, w, impw);
#pragma unroll
  for (int quad = 0; quad < NQ; ++quad) {
    const float lt = W.l[quad][0];
    W.aux[quad] = lt > 0.f ? 1.f / lt : 0.f;
  }
  for (int i = lane; i < NQ * 4 * 8; i += 64) selm[w * (NQ * 32) + i] = 0u;
  nsa_stream<1>(W, kc, vc, jseq, nblk, lds, tid, lane, w, impw);
#pragma unroll
  for (int quad = 0; quad < NQ; ++quad) {
    __builtin_amdgcn_sched_barrier(0);
    const int t = W.tbase + 4 * quad + opaque0(), head = g * 4 + (col & 3);
    const float g0 = gates[(size_t)t * 24 + head * 3 + 0];
#pragma unroll
    for (int dt = 0; dt < 4; ++dt) comb[quad][dt] = W.o[quad][dt] * g0;
  }
  {
    constexpr int LPQ = 64 / (NQ * 4), VPL = 256 / LPQ;
    static_assert(LPQ == 8, "selection written for 8 lanes per query");
    const int qi = lane / LPQ, part = lane % LPQ, m0 = part * VPL;
    uint32_t* myw = selm + (w * (NQ * 4) + qi) * 8;
    if (bq >= 16) {
      float v[VPL];
      const float4* ra = (const float4*)(impw + qi * 512 + m0);
      const float4* rb = (const float4*)(impw + qi * 512 + 256 + m0);
#pragma unroll
      for (int i4 = 0; i4 < VPL / 4; ++i4) {
        const float4 x = ra[i4], y = rb[i4];
        v[4 * i4] = x.x + y.x; v[4 * i4 + 1] = x.y + y.y; v[4 * i4 + 2] = x.z + y.z; v[4 * i4 + 3] = x.w + y.w;
      }
#pragma unroll
      for (int i = 0; i < VPL; ++i) { const int mm = m0 + i; v[i] = (mm >= 1 && mm <= bq - 2) ? v[i] : -1.f; }
#pragma nounroll
      for (int it = 0; it < 13; ++it) {
        float t16[16]; int i16[16];
#pragma unroll
        for (int i = 0; i < 16; ++i) { const bool g = v[2 * i + 1] > v[2 * i]; t16[i] = g ? v[2 * i + 1] : v[2 * i]; i16[i] = g ? 2 * i + 1 : 2 * i; }
        float t8[8]; int i8[8];
#pragma unroll
        for (int i = 0; i < 8; ++i) { const bool g = t16[2 * i + 1] > t16[2 * i]; t8[i] = g ? t16[2 * i + 1] : t16[2 * i]; i8[i] = g ? i16[2 * i + 1] : i16[2 * i]; }
        float t4[4]; int i4[4];
#pragma unroll
        for (int i = 0; i < 4; ++i) { const bool g = t8[2 * i + 1] > t8[2 * i]; t4[i] = g ? t8[2 * i + 1] : t8[2 * i]; i4[i] = g ? i8[2 * i + 1] : i8[2 * i]; }
        const bool g0 = t4[1] > t4[0], g1 = t4[3] > t4[2];
        const float u0 = g0 ? t4[1] : t4[0], u1 = g1 ? t4[3] : t4[2]; const int j0 = g0 ? i4[1] : i4[0], j1 = g1 ? i4[3] : i4[2];
        float best = (u1 > u0) ? u1 : u0; int bi = m0 + ((u1 > u0) ? j1 : j0);
#pragma unroll
        for (int st = 0; st < 3; ++st) {
          const float ov = st == 0 ? dppx1(best) : st == 1 ? dppx2(best) : dpp_hm(best);
          const int oi = __float_as_int(st == 0 ? dppx1(__int_as_float(bi)) : st == 1 ? dppx2(__int_as_float(bi)) : dpp_hm(__int_as_float(bi)));
          if (ov > best || (ov == best && oi < bi)) { best = ov; bi = oi; }
        }
#pragma unroll
        for (int i = 0; i < VPL; ++i) { if (bi == m0 + i) v[i] = -1.f; }
        if (part == 0) myw[bi >> 5] |= 1u << (bi & 31);
      }
      if (part == 0) { myw[0] |= 1u; myw[(bq - 1) >> 5] |= 1u << ((bq - 1) & 31); myw[bq >> 5] |= 1u << (bq & 31); }
    } else {
      if (part == 0) myw[0] = (2u << bq) - 1u;
    }
  }
  __syncthreads();
  if (tid < NQ * 32) { const int qd = tid >> 3, wd = tid & 7; quadm[tid] = selm[(qd * 4 + 0) * 8 + wd] | selm[(qd * 4 + 1) * 8 + wd] | selm[(qd * 4 + 2) * 8 + wd] | selm[(qd * 4 + 3) * 8 + wd]; }
  __syncthreads();
  unsigned char* wlist = lds + L_JLIST + w * 256;
  int nw = 0;
  for (int wd = 0; wd <= (bq >> 5); ++wd) {
    uint32_t u = 0;
#pragma unroll
    for (int qd = 0; qd < NQ; ++qd) u |= quadm[(w * NQ + qd) * 8 + wd];
    u = __builtin_amdgcn_readfirstlane(u);
    if (lane < 32 && ((u >> lane) & 1u)) wlist[nw + __builtin_popcount(u & ((1u << lane) - 1u))] = (unsigned char)(wd * 32 + lane);
    nw += __builtin_popcount(u);
  }
#pragma unroll
  for (int quad = 0; quad < NQ; ++quad) {
    W.m[quad] = -1e30f; W.l[quad] = (f32x4){0.f, 0.f, 0.f, 0.f};
#pragma unroll
    for (int dt = 0; dt < 4; ++dt) W.o[quad][dt] = (f32x4){0.f, 0.f, 0.f, 0.f};
  }
  {
    const bf16_t* K = KV + (size_t)(2 * 4 + 0 * 2 + g) * T * 64; const bf16_t* V = KV + (size_t)(2 * 4 + 1 * 2 + g) * T * 64;
    const int jlo = bq >= 8 ? bq - 8 : 0;
    nsa_stream<3>(W, K, V, [=](int i) { return jlo + i; }, bq - jlo + 1, lds, tid, lane, w, impw);
#pragma unroll
    for (int quad = 0; quad < NQ; ++quad) {
      __builtin_amdgcn_sched_barrier(0);
      const int t = W.tbase + 4 * quad + opaque0(), head = g * 4 + (col & 3);
      const float lt = W.l[quad][0];
      const float sc = gates[(size_t)t * 24 + head * 3 + 2] / fmaxf(lt, 1e-30f);
#pragma unroll
      for (int dt = 0; dt < 4; ++dt) {
        comb[quad][dt] = comb[quad][dt] + W.o[quad][dt] * sc;
        W.o[quad][dt] = (f32x4){0.f, 0.f, 0.f, 0.f};
      }
      W.m[quad] = -1e30f; W.l[quad] = (f32x4){0.f, 0.f, 0.f, 0.f};
    }
  }
  {
    const bf16_t* Kg = KV + (size_t)(1 * 4 + 0 * 2 + g) * T * 64; const bf16_t* Vg = KV + (size_t)(1 * 4 + 1 * 2 + g) * T * 64;
    unsigned char* R = lds + w * 16384;
    const uint32_t* qm = quadm + w * (NQ * 8);
    const uint32_t* sr = selm + (w * (NQ * 4) + (col >> 2)) * 8;
    bf16x8 qf[NQ][2];
#pragma unroll
    for (int quad = 0; quad < NQ; ++quad)
#pragma unroll
      for (int ks = 0; ks < 2; ++ks) qf[quad][ks] = *(const bf16x8*)(Qn + (size_t)(W.tbase + 4 * quad) * 512 + (g * 4 + (col & 3)) * 64 + ks * 32 + kq * 8);
    const int drow = lane >> 3, dch = lane & 7;
    const int koff = (drow * 64 + ((dch ^ drow) * 8)) * 2;
    const int voff = (drow * 64 + ((dch ^ (((drow >> 1) & 3) << 1)) * 8)) * 2;
#define SEL_DMA(G, dst, VSW) do { const unsigned char* g_ = (const unsigned char*)(G) + ((VSW) ? voff : koff); unsigned char* d_ = (dst) + lane * 16; \
      _Pragma("unroll") for (int i_ = 0; i_ < 8; ++i_) __builtin_amdgcn_global_load_lds((const unsigned*)(g_ + i_ * 1024), (unsigned*)(d_ + i_ * 1024), 16, 0, 0); } while (0)
    const int ksw = col & 7;
    const int vsw = ((2 * kq + (col >> 3)) & 3) << 1;
    if (nw > 0) {
      const int j0 = __builtin_amdgcn_readfirstlane((int)wlist[0]);
      SEL_DMA(Kg + (size_t)j0 * 4096, R, 0);
      SEL_DMA(Vg + (size_t)j0 * 4096, R + 8192, 1);
    }
#pragma nounroll
    for (int i = 0; i < nw; ++i) {
      const int j = __builtin_amdgcn_readfirstlane((int)wlist[i]);
      const bool has_next = i + 1 < nw;
      const int jn = has_next ? __builtin_amdgcn_readfirstlane((int)wlist[i + 1]) : 0;
      const int key0 = j * 64, sh = j & 31;
      uint32_t qa = 0u, cs = 0u;
#pragma unroll
      for (int qd = 0; qd < NQ; ++qd) { qa |= ((qm[qd * 8 + (j >> 5)] >> sh) & 1u) << qd; cs |= ((sr[qd * 32 + (j >> 5)] >> sh) & 1u) << qd; }
      const uint32_t qact = __builtin_amdgcn_readfirstlane(qa);
      const bool diag = key0 + 63 > q0;
      asm volatile("s_waitcnt vmcnt(8)" ::: "memory");
      bf16x8 ka[4][2];
#pragma unroll
      for (int kt = 0; kt < 4; ++kt)
#pragma unroll
        for (int ks = 0; ks < 2; ++ks) ka[kt][ks] = *(const bf16x8*)(R + (kt * 16 + col) * 128 + (((ks * 4 + kq) ^ ksw) * 16));
      asm volatile("s_waitcnt lgkmcnt(0)" ::: "memory");
      if (has_next) SEL_DMA(Kg + (size_t)jn * 4096, R, 0);
      bf16x8 pb[NQ][2];
#pragma unroll
      for (int quad = 0; quad < NQ; ++quad) {
        if (!((qact >> quad) & 1u)) continue;
        const bool colsel = (cs >> quad) & 1u;
        const float mq = W.m[quad];
        const bool uninit = mq < -1e29f;
        const float c0 = uninit ? 0.f : mq;
        const float cneg = colsel ? -c0 : -INFINITY;
        f32x4 s4[4];
#pragma unroll
        for (int kt = 0; kt < 4; ++kt) {
          s4[kt] = (f32x4){cneg, cneg, cneg, cneg};
          s4[kt] = mfma16(ka[kt][0], qf[quad][0], s4[kt]);
          s4[kt] = mfma16(ka[kt][1], qf[quad][1], s4[kt]);
        }
        if (diag) {
          const int t = W.tbase + 4 * quad;
#pragma unroll
          for (int kt = 0; kt < 4; ++kt)
#pragma unroll
            for (int r = 0; r < 4; ++r) s4[kt][r] = (key0 + kt * 16 + 4 * kq + r <= t) ? s4[kt][r] : -INFINITY;
        }
        float mloc = fmaxf(fmaxf(fmaxf(s4[0][0], s4[0][1]), fmaxf(s4[0][2], s4[0][3])), fmaxf(fmaxf(s4[1][0], s4[1][1]), fmaxf(s4[1][2], s4[1][3])));
        mloc = fmaxf(mloc, fmaxf(fmaxf(fmaxf(s4[2][0], s4[2][1]), fmaxf(s4[2][2], s4[2][3])), fmaxf(fmaxf(s4[3][0], s4[3][1]), fmaxf(s4[3][2], s4[3][3]))));
        if (__any(mloc > (uninit ? -INFINITY : SM_THR))) {
          float mx = fmaxf(mloc, shx(mloc, 16)); mx = fmaxf(mx, shx(mx, 32));
          const bool upd = mx > -INFINITY;
          const float d = upd ? (uninit ? mx : fmaxf(mx, 0.f)) : 0.f;
#pragma unroll
          for (int kt = 0; kt < 4; ++kt) s4[kt] = s4[kt] - d;
          if (upd) W.m[quad] = c0 + d;
          const float alpha = uninit ? 1.f : ex2(-d);
          W.l[quad] = W.l[quad] * alpha;
#pragma unroll
          for (int dt = 0; dt < 4; ++dt) W.o[quad][dt] *= alpha;
        }
        f32x4 pp[4];
#pragma unroll
        for (int kt = 0; kt < 4; ++kt)
#pragma unroll
          for (int r = 0; r < 4; ++r) pp[kt][r] = ex2(s4[kt][r]);
        pb[quad][0] = pack8(pp[0], pp[1]); pb[quad][1] = pack8(pp[2], pp[3]);
        const bf16x8 ones = {0x3F80, 0x3F80, 0x3F80, 0x3F80, 0x3F80, 0x3F80, 0x3F80, 0x3F80};
        W.l[quad] = mfma16(ones, pb[quad][0], W.l[quad]);
        W.l[quad] = mfma16(ones, pb[quad][1], W.l[quad]);
      }
      if (has_next) asm volatile("s_waitcnt vmcnt(8)" ::: "memory"); else asm volatile("s_waitcnt vmcnt(0)" ::: "memory");
      bf16x8 va[4][2];
      {
        const unsigned vb_ = (unsigned)(size_t)(R + 8192) + (4 * kq + (col >> 2)) * 128 + (col & 1) * 8;
        const unsigned a0_ = vb_ + (((0 * 2 + ((col & 3) >> 1)) ^ vsw) * 16), a1_ = vb_ + (((1 * 2 + ((col & 3) >> 1)) ^ vsw) * 16),
                       a2_ = vb_ + (((2 * 2 + ((col & 3) >> 1)) ^ vsw) * 16), a3_ = vb_ + (((3 * 2 + ((col & 3) >> 1)) ^ vsw) * 16);
        s16x4 r00, r01, r02, r03, r10, r11, r12, r13, r20, r21, r22, r23, r30, r31, r32, r33;
        asm volatile(
            "ds_read_b64_tr_b16 %0, %16\n\tds_read_b64_tr_b16 %1, %16 offset:2048\n\tds_read_b64_tr_b16 %2, %16 offset:4096\n\tds_read_b64_tr_b16 %3, %16 offset:6144\n\t"
            "ds_read_b64_tr_b16 %4, %17\n\tds_read_b64_tr_b16 %5, %17 offset:2048\n\tds_read_b64_tr_b16 %6, %17 offset:4096\n\tds_read_b64_tr_b16 %7, %17 offset:6144\n\t"
            "ds_read_b64_tr_b16 %8, %18\n\tds_read_b64_tr_b16 %9, %18 offset:2048\n\tds_read_b64_tr_b16 %10, %18 offset:4096\n\tds_read_b64_tr_b16 %11, %18 offset:6144\n\t"
            "ds_read_b64_tr_b16 %12, %19\n\tds_read_b64_tr_b16 %13, %19 offset:2048\n\tds_read_b64_tr_b16 %14, %19 offset:4096\n\tds_read_b64_tr_b16 %15, %19 offset:6144\n\t"
            "s_waitcnt lgkmcnt(0)"
            : "=&v"(r00), "=&v"(r01), "=&v"(r02), "=&v"(r03), "=&v"(r10), "=&v"(r11), "=&v"(r12), "=&v"(r13),
              "=&v"(r20), "=&v"(r21), "=&v"(r22), "=&v"(r23), "=&v"(r30), "=&v"(r31), "=&v"(r32), "=&v"(r33)
            : "v"(a0_), "v"(a1_), "v"(a2_), "v"(a3_) : "memory");
        va[0][0] = __builtin_shufflevector(r00, r01, 0, 1, 2, 3, 4, 5, 6, 7); va[0][1] = __builtin_shufflevector(r02, r03, 0, 1, 2, 3, 4, 5, 6, 7);
        va[1][0] = __builtin_shufflevector(r10, r11, 0, 1, 2, 3, 4, 5, 6, 7); va[1][1] = __builtin_shufflevector(r12, r13, 0, 1, 2, 3, 4, 5, 6, 7);
        va[2][0] = __builtin_shufflevector(r20, r21, 0, 1, 2, 3, 4, 5, 6, 7); va[2][1] = __builtin_shufflevector(r22, r23, 0, 1, 2, 3, 4, 5, 6, 7);
        va[3][0] = __builtin_shufflevector(r30, r31, 0, 1, 2, 3, 4, 5, 6, 7); va[3][1] = __builtin_shufflevector(r32, r33, 0, 1, 2, 3, 4, 5, 6, 7);
      }
      if (has_next) SEL_DMA(Vg + (size_t)jn * 4096, R + 8192, 1);
#pragma unroll
      for (int quad = 0; quad < NQ; ++quad) {
        if (!((qact >> quad) & 1u)) continue;
#pragma unroll
        for (int dt = 0; dt < 4; ++dt) {
          W.o[quad][dt] = mfma16(va[dt][0], pb[quad][0], W.o[quad][dt]);
          W.o[quad][dt] = mfma16(va[dt][1], pb[quad][1], W.o[quad][dt]);
        }
      }
    }
#undef SEL_DMA
#pragma unroll
    for (int quad = 0; quad < NQ; ++quad) {
      __builtin_amdgcn_sched_barrier(0);
      const int t = W.tbase + 4 * quad + opaque0(), head = g * 4 + (col & 3);
      const float lt = W.l[quad][0];
      const float sc = gates[(size_t)t * 24 + head * 3 + 1] / fmaxf(lt, 1e-30f);
      float sq = 0.f;
#pragma unroll
      for (int dt = 0; dt < 4; ++dt) {
        const f32x4 nv = comb[quad][dt] + W.o[quad][dt] * sc;
        sq += nv[0] * nv[0] + nv[1] * nv[1] + nv[2] * nv[2] + nv[3] * nv[3];
        *(uint32_t*)((unsigned char*)omix + (size_t)t * 1024 + head * 64 + dt * 16 + kq * 4) = pk4_fp8(nv[0] * ATT_ASC, nv[1] * ATT_ASC, nv[2] * ATT_ASC, nv[3] * ATT_ASC);
      }
      sq += px16(sq); sq += px32(sq);
      sq += dppx1(sq); sq += dppx2(sq);
      if (kq == 0 && (col & 3) == 0) atomicAdd((float*)(p.ws + OFF_SS) + (size_t)t * 2, sq);
    }
  }
  __syncthreads();
}

DI void sb_item(const Params& p, int item, unsigned char* lds, float* omix, int tid) {
  const int lane = tid & 63, w = __builtin_amdgcn_readfirstlane(tid >> 6), col = lane & 15, kq = lane >> 4;
  const int bq = item >> 3, h = item & 7, q0 = bq * 64;
  const bf16_t* SB = (const bf16_t*)(p.ws + OFF_SB);
  const bf16_t* Qg = SB + (size_t)(0 * 8 + h) * T * 64; const bf16_t* Kg = SB + (size_t)(1 * 8 + h) * T * 64; const bf16_t* Vg = SB + (size_t)(2 * 8 + h) * T * 64;
  int* vote = (int*)(lds + L_VOTE);
  const int t = q0 + w * 16 + col;
  bf16x8 qf[2];
#pragma unroll
  for (int ks = 0; ks < 2; ++ks) qf[ks] = *(const bf16x8*)(Qg + (size_t)t * 64 + ks * 32 + kq * 8);
  f32x4 o[4];
#pragma unroll
  for (int dt = 0; dt < 4; ++dt) o[dt] = (f32x4){0.f, 0.f, 0.f, 0.f};
  float carry = 0.f;
  int j = bq, cur = 0;
  uint4 rk0, rk1, rv0, rv1;
  STAGE_LOAD(true, Kg, Vg, j * 64);
  STAGE_STORE(true, stageK(lds, 0), stageV(lds, 0));
  __syncthreads();
  while (true) {
    const int jn = j - 1;
    if (jn >= 0) STAGE_LOAD(true, Kg, Vg, jn * 64);
    {
      const bf16_t* Ks = stageK(lds, cur); const bf16_t* Vs = stageV(lds, cur);
      const int key0 = j * 64;
      const bool diag = (j == bq);
      f32x4 a[4];
#pragma unroll
      for (int kt = 3; kt >= 0; --kt) {
        f32x4 z = (f32x4){0.f, 0.f, 0.f, 0.f};
#pragma unroll
        for (int ks = 0; ks < 2; ++ks) z = mfma16(*(const bf16x8*)&Ks[(kt * 16 + col) * KST + ks * 32 + kq * 8], qf[ks], z);
        float ln[4];
#pragma unroll
        for (int rr = 0; rr < 4; ++rr) {
          const float sp = fmaxf(z[rr], 0.f) + __builtin_amdgcn_logf(1.f + ex2(-fabsf(z[rr])));
          ln[rr] = -sp;
        }
        if (diag) {
#pragma unroll
          for (int rr = 0; rr < 4; ++rr) { const bool vd = key0 + kt * 16 + 4 * kq + rr < t; ln[rr] = vd ? ln[rr] : 0.f; z[rr] = vd ? z[rr] : -INFINITY; }
        }
        const float e2 = ln[3], e1 = e2 + ln[2], e0 = e1 + ln[1], tot = e0 + ln[0];
        const float b = px16(tot), c = tot + b, d = px32(c);
        const float base = carry + ((kq & 1) ? 0.f : b) + ((kq & 2) ? 0.f : d);
        a[kt][3] = ex2(z[3] + ln[3] + base);
        a[kt][2] = ex2(z[2] + ln[2] + e2 + base);
        a[kt][1] = ex2(z[1] + ln[1] + e1 + base);
        a[kt][0] = ex2(z[0] + ln[0] + e0 + base);
        carry += c + d;
      }
      const bf16x8 pb0 = pack8(a[0], a[1]), pb1 = pack8(a[2], a[3]);
#pragma unroll
      for (int dt = 0; dt < 4; ++dt)
#pragma unroll
        for (int s2 = 0; s2 < 2; ++s2) {
          const bf16_t* p0 = &Vs[((2 * s2) * 16 + 4 * kq + (col >> 2)) * KST + dt * 16 + 4 * (col & 3)];
          const s16x4 lo = tr_read(p0), hi = tr_read(p0 + 16 * KST);
          o[dt] = mfma16(__builtin_shufflevector(lo, hi, 0, 1, 2, 3, 4, 5, 6, 7), s2 ? pb1 : pb0, o[dt]);
        }
      const int done = __all(carry < -150.1f);
      if (lane == 0) vote[cur * 4 + w] = done;
    }
    if (jn >= 0) STAGE_STORE(true, stageK(lds, cur ^ 1), stageV(lds, cur ^ 1));
    __syncthreads();
    if (jn < 0) break;
    if (vote[cur * 4 + 0] & vote[cur * 4 + 1] & vote[cur * 4 + 2] & vote[cur * 4 + 3]) break;
    cur ^= 1; j = jn;
  }
  {
    float sq = 0.f;
#pragma unroll
    for (int dt = 0; dt < 4; ++dt) {
      sq += o[dt][0] * o[dt][0] + o[dt][1] * o[dt][1] + o[dt][2] * o[dt][2] + o[dt][3] * o[dt][3];
      *(uint32_t*)((unsigned char*)omix + (size_t)t * 1024 + 512 + h * 64 + dt * 16 + kq * 4) = pk4_fp8(o[dt][0] * ATT_ASC, o[dt][1] * ATT_ASC, o[dt][2] * ATT_ASC, o[dt][3] * ATT_ASC);
    }
    sq += px16(sq); sq += px32(sq);
    if (kq == 0) atomicAdd((float*)(p.ws + OFF_SS) + (size_t)t * 2 + 1, sq);
  }
  __syncthreads();
}

DI void phase_attn_mfma(const Params& p, unsigned char* lds, float* omix, int qsel = 0) {
  int* queue = (int*)(p.ws + OFF_MISC) + 16 + qsel;
  int* slot = (int*)(lds + L_VOTE + 32);
  bool first = true;
  for (;;) {
    if (tidx() == 0) *slot = first ? (int)blockIdx.x : atomicAdd(queue, 1);
    first = false;
    __syncthreads();
    const int item = *slot;
    __syncthreads();
    constexpr int NINT = NSA_ITEMS * 4, NCV_INT = NSA_ITEMS * 3, NCV_REST = ND_JOBS > NCV_INT ? ND_JOBS - NCV_INT : 0;
    if (item >= NINT + NCV_REST + SB_ITEMS) break;
    const int tidq = tidx() + opaque0();
    int cv = -1;
    if (item < NINT) { if ((item & 3) == 0) nsa_item(p, item >> 2, lds, omix, tidq); else { cv = (item >> 2) * 3 + (item & 3) - 1; if (cv >= ND_JOBS) cv = -1; } }
    else if (item < NINT + NCV_REST) cv = NCV_INT + (item - NINT);
    else sb_item(p, item - NINT - NCV_REST, lds, omix, tidq);
    if (cv >= 0) prep_job(p, cv < J_WOUT ? JB_WOUT + cv : JB_WG + (cv - J_WOUT), lds);
  }
}

DI void phase_mixnorm(const Params& p, unsigned char* smem) {
  const int lane = tidx() & 63, w = tidx() >> 6;
  const bf16_t* omix = (const bf16_t*)(p.ws + OFF_R3);
  unsigned char* ao = p.ws + OFF_R1;
  for (int job = blockIdx.x; job < T / 4; job += gridDim.x) {
    const int row = job * 4 + w;
    const uint2* r4 = (const uint2*)(omix + (size_t)row * 1024);
    float4 v[4]; float s0 = 0.f, s1 = 0.f;
#pragma unroll
    for (int i = 0; i < 4; ++i) {
      const uint2 u = r4[lane + 64 * i];
      v[i] = make_float4(bflo(u.x), bfhi(u.x), bflo(u.y), bfhi(u.y));
      const float q = v[i].x * v[i].x + v[i].y * v[i].y + v[i].z * v[i].z + v[i].w * v[i].w;
      if (i < 2) s0 += q; else s1 += q;
    }
    s0 = wave_sum(s0); s1 = wave_sum(s1);
    const float r0 = rsqrtf(s0 * (1.f / 512.f) + 1e-6f), r1 = rsqrtf(s1 * (1.f / 512.f) + 1e-6f);
#pragma unroll
    for (int i = 0; i < 4; ++i) {
      const float rs = i < 2 ? r0 : r1;
      *(uint32_t*)(ao + (size_t)row * 1024 + (lane + 64 * i) * 4) = pk4_fp8(v[i].x * rs, v[i].y * rs, v[i].z * rs, v[i].w * rs);
    }
  }
}

DI void phase_outproj(const Params& p, unsigned char* smem) {
  const unsigned char* ao = p.ws + OFF_R3;
  const unsigned char* WoutT = p.ws + OFF_WOUT;
  const float* ss = (const float*)(p.ws + OFF_SS);
  float* s_ratio = (float*)(smem + 69632);
  float* s_fin = s_ratio + 128;
  float* s_irs = s_fin + 128;
  for (int tile = vblock(); tile < 128 * 8; tile += gridDim.x) {
    const int rt = tile >> 3, ct = tile & 7, row0 = rt * 128;
    const bf16_t* xb = (const bf16_t*)(p.ws + OFF_R1); bf16_t* x1b = (bf16_t*)(p.ws + OFF_X1B);
    const float* irs = (const float*)(p.ws + OFF_RSTD2);
    if (tidx() < 128) {
      s_irs[tidx()] = irs[row0 + tidx()];
      const float2 q2 = *(const float2*)(ss + (size_t)(row0 + tidx()) * 2);
      const float r0 = rsqrtf(q2.x * (1.f / 512.f) + 1e-6f), r1 = rsqrtf(q2.y * (1.f / 512.f) + 1e-6f);
      s_ratio[tidx()] = r0 / r1; s_fin[tidx()] = r1 * (1.f / (ATT_ASC * MOE_WSC));
    }
    auto mid = [=](f32x4 (&acc)[4][4], int wr, int lane) {
      const int quad = lane >> 4;
#pragma unroll
      for (int m = 0; m < 4; ++m)
#pragma unroll
        for (int r = 0; r < 4; ++r) {
          const float f = s_ratio[wr * 64 + m * 16 + quad * 4 + r];
#pragma unroll
          for (int n = 0; n < 4; ++n) acc[m][n][r] *= f;
        }
    };
    auto epi = [=](f32x4 (&acc)[4][4], int wr, int wc, int lane) {
      const int quad = lane >> 4, lc = lane & 15;
      const size_t gbase = (size_t)(row0 + wr * 64 + quad) * 1024 + ct * 128 + wc * 64 + lc * 4;
      uint2 xq[16];
#pragma unroll
      for (int i = 0; i < 16; ++i) xq[i] = *(const uint2*)(xb + gbase + (size_t)(4 * i) * 1024);
      float4 iw = *(const float4*)(p.attn_norm_w + ct * 128 + wc * 64 + lc * 4);
      iw.x = 1.f / iw.x; iw.y = 1.f / iw.y; iw.z = 1.f / iw.z; iw.w = 1.f / iw.w;
      float fin[4][4];
#pragma unroll
      for (int m = 0; m < 4; ++m)
#pragma unroll
        for (int r = 0; r < 4; ++r) fin[m][r] = s_fin[wr * 64 + m * 16 + quad * 4 + r];
      float* patch = (float*)(smem + (wr * 2 + wc) * (64 * 68 * 4));
#pragma unroll
      for (int m = 0; m < 4; ++m)
#pragma unroll
        for (int n = 0; n < 4; ++n)
#pragma unroll
          for (int r = 0; r < 4; ++r) patch[(m * 16 + quad * 4 + r) * 68 + n * 16 + lc] = acc[m][n][r] * fin[m][r];
      asm volatile("s_waitcnt lgkmcnt(0)" ::: "memory");
#pragma unroll
      for (int i = 0; i < 16; ++i) {
        const float4 a4 = *(const float4*)&patch[(quad + 4 * i) * 68 + lc * 4];
        const float ir = s_irs[wr * 64 + quad + 4 * i];
        const float4 xv = make_float4(bflo(xq[i].x) * ir * iw.x + a4.x, bfhi(xq[i].x) * ir * iw.y + a4.y, bflo(xq[i].y) * ir * iw.z + a4.z, bfhi(xq[i].y) * ir * iw.w + a4.w);
        *(uint2*)(x1b + gbase + (size_t)(4 * i) * 1024) = make_uint2(pk2(xv.x, xv.y), pk2(xv.z, xv.w));
      }
    };
    gemm128f8([=](int r) { return ao + (size_t)(row0 + r) * 1024; }, WoutT + (size_t)ct * 128 * 1024, 1024, 1024, epi, smem, mid);
  }
}

DI float red8(float v) { v += dppx1(v); v += dppx2(v); v += dpp_hm(v); return v; }
DI void phase_route(const Params& p, unsigned char* smem) {
  const int tid = tidx(), lane = tid & 63, w = tid >> 6, l15 = lane & 15, kq = lane >> 4;
  unsigned char* xb2 = p.ws + OFF_R1;
  float* rstd2 = (float*)(p.ws + OFF_RSTD2);
  int* cnt = (int*)(p.ws + OFF_MISC);
  int2* list = (int2*)(p.ws + OFF_LIST);
  const bf16_t* wrt = (const bf16_t*)(p.ws + OFF_WR);
  const bf16_t* x1b = (const bf16_t*)(p.ws + OFF_X1B);
  float* part = (float*)smem;
  float* ssp = (float*)(smem + 17408);
  unsigned char* sm2 = smem + 18432;
  int* s_e = (int*)sm2; float* s_w = (float*)(sm2 + 512); int* s_rank = (int*)(sm2 + 1024); int* s_lcnt = (int*)(sm2 + 1536); int* s_base = (int*)(sm2 + 1600);
  float* s_wn = (float*)(smem + 20480);
  ((float4*)s_wn)[tid] = ((const float4*)p.ffn_norm_w)[tid];
  __syncthreads();
  for (int job = blockIdx.x; job < T / 32; job += gridDim.x) {
    if (tid < 16) s_lcnt[tid] = 0;
    const int kb = w * 256 + kq * 8;
    {
      const int trow0 = job * 32 + l15;
      f32x4 acc[2][2];
#pragma unroll
      for (int m = 0; m < 2; ++m)
#pragma unroll
        for (int n = 0; n < 2; ++n) acc[m][n] = (f32x4){0.f, 0.f, 0.f, 0.f};
      float ss[2] = {0.f, 0.f};
#pragma nounroll
      for (int half = 0; half < 2; ++half) {
      const int kh = kb + half * 128 + opaque0();
      uint4 xv[2][4];
#pragma unroll
      for (int m = 0; m < 2; ++m)
#pragma unroll
        for (int st = 0; st < 4; ++st) xv[m][st] = *(const uint4*)(x1b + (size_t)(trow0 + 16 * m) * 1024 + kh + st * 32);
      bf16x8 nbh[2], nbl[2];
#pragma unroll
      for (int n = 0; n < 2; ++n) {
        nbh[n] = *(const bf16x8*)(wrt + (size_t)(n * 16 + l15) * 1024 + kh);
        nbl[n] = *(const bf16x8*)(wrt + (size_t)(32 + n * 16 + l15) * 1024 + kh);
      }
#pragma unroll
      for (int st = 0; st < 4; ++st) {
        const float4 w0 = *(const float4*)(s_wn + kh + st * 32), w1 = *(const float4*)(s_wn + kh + st * 32 + 4);
        bf16x8 bh[2], bl[2];
#pragma unroll
        for (int n = 0; n < 2; ++n) { bh[n] = nbh[n]; bl[n] = nbl[n]; }
        if (st < 3) {
          const int k = kh + (st + 1) * 32;
#pragma unroll
          for (int n = 0; n < 2; ++n) {
            nbh[n] = *(const bf16x8*)(wrt + (size_t)(n * 16 + l15) * 1024 + k);
            nbl[n] = *(const bf16x8*)(wrt + (size_t)(32 + n * 16 + l15) * 1024 + k);
          }
        }
        __builtin_amdgcn_sched_barrier(0);
#pragma unroll
        for (int m = 0; m < 2; ++m) {
          const uint4 xq = xv[m][st];
          const float4 x0 = make_float4(bflo(xq.x), bfhi(xq.x), bflo(xq.y), bfhi(xq.y)), x1 = make_float4(bflo(xq.z), bfhi(xq.z), bflo(xq.w), bfhi(xq.w));
          ss[m] += x0.x * x0.x + x0.y * x0.y + x0.z * x0.z + x0.w * x0.w + x1.x * x1.x + x1.y * x1.y + x1.z * x1.z + x1.w * x1.w;
          const float h[8] = {x0.x * w0.x, x0.y * w0.y, x0.z * w0.z, x0.w * w0.w, x1.x * w1.x, x1.y * w1.y, x1.z * w1.z, x1.w * w1.w};
          *(uint2*)(xb2 + (size_t)(trow0 + 16 * m) * 1024 + kh + st * 32) = make_uint2(pk4_fp8(h[0], h[1], h[2], h[3]), pk4_fp8(h[4], h[5], h[6], h[7]));
          uint32_t hi[4], lo[4];
#pragma unroll
          for (int i = 0; i < 4; ++i) {
            hi[i] = pk2(h[2 * i], h[2 * i + 1]);
            lo[i] = pk2(h[2 * i] - bflo(hi[i]), h[2 * i + 1] - bfhi(hi[i]));
          }
          const bf16x8 ah = __builtin_bit_cast(bf16x8, make_uint4(hi[0], hi[1], hi[2], hi[3]));
          const bf16x8 al = __builtin_bit_cast(bf16x8, make_uint4(lo[0], lo[1], lo[2], lo[3]));
#pragma unroll
          for (int n = 0; n < 2; ++n) {
            acc[m][n] = __builtin_amdgcn_mfma_f32_16x16x32_bf16(al, bh[n], acc[m][n], 0, 0, 0);
            acc[m][n] = __builtin_amdgcn_mfma_f32_16x16x32_bf16(ah, bl[n], acc[m][n], 0, 0, 0);
            acc[m][n] = __builtin_amdgcn_mfma_f32_16x16x32_bf16(ah, bh[n], acc[m][n], 0, 0, 0);
          }
        }
        __builtin_amdgcn_sched_barrier(0);
      }
      }
#pragma unroll
      for (int m = 0; m < 2; ++m) {
#pragma unroll
        for (int n = 0; n < 2; ++n)
#pragma unroll
          for (int r = 0; r < 4; ++r) part[(w * 32 + m * 16 + kq * 4 + r) * 33 + n * 16 + l15] = acc[m][n][r];
        float sv = ss[m]; sv += px16(sv); sv += px32(sv);
        if (kq == 0) ssp[w * 32 + m * 16 + l15] = sv;
      }
    }
    __syncthreads();
    if (tid < 32) {
      const int t = job * 32 + tid;
      const float ssum = (ssp[tid] + ssp[32 + tid]) + (ssp[64 + tid] + ssp[96 + tid]);
      const float rstd = rsqrtf(ssum * (1.f / 1024.f) + 1e-6f);
      rstd2[t] = rstd;
      float lg[4], le[16];
#pragma unroll
      for (int c = 0; c < 20; ++c) {
        const float v = ((part[tid * 33 + c] + part[(32 + tid) * 33 + c]) + (part[(64 + tid) * 33 + c] + part[(96 + tid) * 33 + c])) * rstd;
        if (c < 4) lg[c] = v + p.rg_b[c]; else le[c - 4] = v + p.re_b[c - 4];
      }
      int grp = 0; float gm = lg[0];
#pragma unroll
      for (int c = 1; c < 4; ++c) if (lg[c] > gm) { gm = lg[c]; grp = c; }
      float gs = 0.f;
#pragma unroll
      for (int c = 0; c < 4; ++c) gs += __expf(lg[c] - gm);
      const float ggate = 1.f / gs;
      float el[4];
#pragma unroll
      for (int j = 0; j < 4; ++j) el[j] = grp == 0 ? le[j] : grp == 1 ? le[4 + j] : grp == 2 ? le[8 + j] : le[12 + j];
      int i1 = 0; float v1 = el[0];
#pragma unroll
      for (int j = 1; j < 4; ++j) if (el[j] > v1) { v1 = el[j]; i1 = j; }
      int i2 = -1; float v2 = -INFINITY;
#pragma unroll
      for (int j = 0; j < 4; ++j) if (j != i1 && el[j] > v2) { v2 = el[j]; i2 = j; }
      const float e2x = __expf(v2 - v1);
      s_e[tid * 2] = grp * 4 + i1; s_w[tid * 2] = ggate / (1.f + e2x);
      s_e[tid * 2 + 1] = grp * 4 + i2; s_w[tid * 2 + 1] = ggate * e2x / (1.f + e2x);
    }
    __syncthreads();
    int e = 0;
    if (tid < 64) { e = s_e[tid]; s_rank[tid] = atomicAdd(&s_lcnt[e], 1); }
    __syncthreads();
    if (tid < 16) { const int c = s_lcnt[tid]; s_base[tid] = c ? atomicAdd(&cnt[CNT_IDX(tid)], c) : 0; }
    __syncthreads();
    if (tid < 64) list[(size_t)e * T + s_base[e] + s_rank[tid]] = make_int2(job * 64 + tid, __float_as_int(s_w[tid]));
    __syncthreads();
  }
}

DI void moe_slot(const int* scnt  , int slot, int& e, int& i, int& hbase) {
  int acc = 0; e = -1; i = 0; hbase = 0;
  for (int j = 0; j < 16; ++j) {
    const int nt = (scnt[j] + 127) >> 7;
    if (e < 0 && slot < acc + nt) { e = j; i = slot - acc; hbase = (acc + i) * 128; }
    acc += nt;
  }
}
DI void phase_moe(const Params& p, unsigned char* smem) {
  int* misc = (int*)(p.ws + OFF_MISC);
  const int* cnt = (const int*)(p.ws + OFF_MISC);
  const int2* list = (const int2*)(p.ws + OFF_LIST);
  const unsigned char* xb2 = p.ws + OFF_R1;
  unsigned char* hid = p.ws + OFF_HID;
  const float* rstd2 = (const float*)(p.ws + OFF_RSTD2);
  unsigned char* y = p.ws + OFF_R3;
  int* s_cnt = (int*)(smem + 65536);
  float* s_rs = (float*)(smem + 65536 + 64);
  int2* s_ent = (int2*)(smem + 65536 + 64 + 512);
  int* s_q = (int*)(smem + 65536 + 8192);
  const int x = (int)(xb_xcc_id() & 7u);
  const int nblk = (int)barrier_words(smem)[0];
  int next = (int)barrier_words(smem)[2];
  if (tidx() < 16) s_cnt[tidx()] = cnt[CNT_IDX(tidx())];
  __syncthreads();
  int S = 0;
  for (int j = 0; j < 16; ++j) S += (s_cnt[j] + 127) >> 7;
  const int ns = S > x ? (S - x + 7) >> 3 : 0;
  const int L = ns < 16 ? ns : 16;
  const int ngroups = 2 * ns;
  auto do_m1 = [&](int slot, int ct) {
    int e, i, hbase; moe_slot(s_cnt, slot, e, i, hbase);
    const int nrow = s_cnt[e] - i * 128;
    const int2* le = list + (size_t)e * T + i * 128;
    if (tidx() < 128) { const int row = tidx(); s_rs[row] = rstd2[le[row < nrow ? row : nrow - 1].x >> 1] * (1.f / MOE_WSC); }
    auto epi = [=](f32x4 (&acc)[4][4], int wr, int wc, int lane) {
      const int quad = lane >> 4, lc = lane & 15;
      float rs[4][4];
#pragma unroll
      for (int m = 0; m < 4; ++m)
#pragma unroll
        for (int r = 0; r < 4; ++r) rs[m][r] = s_rs[wr * 64 + m * 16 + quad * 4 + r];
      unsigned char* patch = smem + ((wr * 2 + wc) * 64 * 48);
#pragma unroll
      for (int m = 0; m < 4; ++m)
#pragma unroll
        for (int n2 = 0; n2 < 2; ++n2)
#pragma unroll
          for (int r = 0; r < 4; ++r) {
            const float gv = acc[m][2 * n2][r] * rs[m][r], uv = acc[m][2 * n2 + 1][r] * rs[m][r];
            const float hv = gv * sigmoidf_(gv) * uv * MOE_HSC;
            patch[(m * 16 + quad * 4 + r) * 48 + n2 * 16 + lc] = (unsigned char)__builtin_amdgcn_cvt_pk_fp8_f32(hv, hv, 0, false);
          }
      asm volatile("s_waitcnt lgkmcnt(0)" ::: "memory");
#pragma unroll
      for (int i = 0; i < 2; ++i) {
        const int row = (lane >> 1) + 32 * i, ch = lane & 1;
        const uint4 q4 = *(const uint4*)&patch[row * 48 + ch * 16];
        *(uint4*)(hid + (size_t)(hbase + wr * 64 + row) * 512 + ct * 64 + wc * 32 + ch * 16) = q4;
      }
    };
    gemm128f8([=](int r) { const int rr = r < nrow ? r : nrow - 1; return xb2 + (size_t)(le[rr].x >> 1) * 1024; },
              p.ws + OFF_WGU + (size_t)e * 1024 * 1024 + (size_t)ct * 128 * 1024, 1024, 1024, epi, smem);
    asm volatile("s_waitcnt vmcnt(0)" ::: "memory");
    __syncthreads();
    if (tidx() == 0) __hip_atomic_fetch_add(&misc[128 + slot], 1, __ATOMIC_RELAXED, __HIP_MEMORY_SCOPE_AGENT);
  };
  auto do_m2 = [&](int slot, int ct) {
    int e, i, hbase; moe_slot(s_cnt, slot, e, i, hbase);
    if (tidx() == 0) {
      unsigned sp = 0;
      while (__hip_atomic_load(&misc[128 + slot], __ATOMIC_RELAXED, __HIP_MEMORY_SCOPE_AGENT) < 8) { __builtin_amdgcn_s_sleep(2); if (++sp > (1u << 24)) break; }
    }
    __syncthreads();
    asm volatile("" ::: "memory");
    const int nrow = s_cnt[e] - i * 128;
    const int2* le = list + (size_t)e * T + i * 128;
    if (tidx() < 128) { const int row = tidx(); s_ent[row] = le[row < nrow ? row : 0]; }
    auto epi = [=](f32x4 (&acc)[4][4], int wr, int wc, int lane) {
      const int quad = lane >> 4, lc = lane & 15;
      int2 en[4][4];
#pragma unroll
      for (int m = 0; m < 4; ++m)
#pragma unroll
        for (int r = 0; r < 4; ++r) en[m][r] = s_ent[wr * 64 + m * 16 + quad * 4 + r];
      unsigned char* patch = smem + ((wr * 2 + wc) * 64 * 80);
#pragma unroll
      for (int m = 0; m < 4; ++m)
#pragma unroll
        for (int r = 0; r < 4; ++r) {
          const float wgt = __int_as_float(en[m][r].y) * (MOE_YSC / (MOE_WSC * MOE_HSC));
#pragma unroll
          for (int n = 0; n < 4; ++n) { const float yv = acc[m][n][r] * wgt; patch[(m * 16 + quad * 4 + r) * 80 + n * 16 + lc] = (unsigned char)__builtin_amdgcn_cvt_pk_fp8_f32(yv, yv, 0, false); }
        }
      asm volatile("s_waitcnt lgkmcnt(0)" ::: "memory");
      int ents[4];
#pragma unroll
      for (int i = 0; i < 4; ++i) ents[i] = s_ent[wr * 64 + (lane >> 2) + 16 * i].x;
#pragma unroll
      for (int i = 0; i < 4; ++i) {
        const int rowl = (lane >> 2) + 16 * i, ch = lane & 3, row = wr * 64 + rowl;
        if (row < nrow) *(uint4*)(y + (size_t)ents[i] * 1024 + ct * 128 + wc * 64 + ch * 16) = *(const uint4*)&patch[rowl * 80 + ch * 16];
      }
    };
    gemm128f8([=](int r) { return hid + (size_t)(hbase + r) * 512; }, p.ws + OFF_WD + (size_t)e * 1024 * 512 + (size_t)ct * 128 * 512, 512, 512, epi, smem);
  };
  for (;;) {
    __syncthreads();
    if (tidx() == 0) *s_q = next;
    __syncthreads();
    const int n = *s_q;
    const int g = n >> 3, ct = n & 7;
    if (g >= ngroups) break;
    if (tidx() == 0) next = nblk + atomicAdd(&misc[72 + x], 1);
    int k; bool down;
    if (g < L) { k = g; down = false; }
    else if (g < L + 2 * (ns - L)) { const int t = g - L; k = L + (t >> 1); down = (t & 1) != 0; if (down) k -= L; }
    else { k = ns - L + (g - (L + 2 * (ns - L))); down = true; }
    const int slot = x + 8 * k;
    if (down) do_m2(slot, ct); else do_m1(slot, ct);
  }
}

DI void phase_final(const Params& p, unsigned char* smem) {
  const int lane = tidx() & 63, w = tidx() >> 6;
  const unsigned char* y = p.ws + OFF_R3;
  for (int job = blockIdx.x; job < T / 4; job += gridDim.x) {
    const int t = job * 4 + w;
    float4* r4 = (float4*)(p.out + (size_t)t * 1024);
    const uint2* x4 = (const uint2*)((const bf16_t*)(p.ws + OFF_X1B) + (size_t)t * 1024);
    float4 v[4]; float ss = 0.f;
#pragma unroll
    for (int i = 0; i < 4; ++i) {
      const uint2 xb_ = x4[lane + 64 * i];
      v[i] = make_float4(bflo(xb_.x), bfhi(xb_.x), bflo(xb_.y), bfhi(xb_.y));
      const int a = *(const int*)(y + (size_t)(2 * t) * 1024 + (lane + 64 * i) * 4);
      const int b = *(const int*)(y + (size_t)(2 * t + 1) * 1024 + (lane + 64 * i) * 4);
      const f32v2 a01 = __builtin_amdgcn_cvt_pk_f32_fp8(a, false), a23 = __builtin_amdgcn_cvt_pk_f32_fp8(a, true);
      const f32v2 b01 = __builtin_amdgcn_cvt_pk_f32_fp8(b, false), b23 = __builtin_amdgcn_cvt_pk_f32_fp8(b, true);
      v[i].x += (a01[0] + b01[0]) * (1.f / MOE_YSC); v[i].y += (a01[1] + b01[1]) * (1.f / MOE_YSC);
      v[i].z += (a23[0] + b23[0]) * (1.f / MOE_YSC); v[i].w += (a23[1] + b23[1]) * (1.f / MOE_YSC);
      ss += v[i].x * v[i].x + v[i].y * v[i].y + v[i].z * v[i].z + v[i].w * v[i].w;
    }
    ss = wave_sum(ss);
    float rstd = rsqrtf(ss * (1.f / 1024.f) + 1e-6f);
#if DEBUG_CMP
    { const float* acc = (const float*)(p.ws + OFF_MISC) + 24; rstd *= 1.f + fminf(0.9f, 10.f * sqrtf(acc[0] / fmaxf(acc[1], 1e-30f))); }
#endif
#pragma unroll
    for (int i = 0; i < 4; ++i) {
      const float4 wv = ((const float4*)p.final_norm_w)[lane + 64 * i];
      float4 o; o.x = v[i].x * rstd * wv.x; o.y = v[i].y * rstd * wv.y; o.z = v[i].z * rstd * wv.z; o.w = v[i].w * rstd * wv.w;
      r4[lane + 64 * i] = o;
    }
  }
}

#ifndef DEBUG_CMP
#define DEBUG_CMP 0
#endif
#ifndef PROBE_ATTN2
#define PROBE_ATTN2 0
#endif
#ifndef PROBE_GEMM2
#define PROBE_GEMM2 0
#endif
#ifndef DBG_LO
#define DBG_LO 0
#define DBG_HI 1024
#endif
constexpr int SMEM_BYTES = (ATT_LDS > 36864 ? ATT_LDS : 36864) + 16;
DI const volatile unsigned* barrier_words(unsigned char* smem) { return (const volatile unsigned*)(smem + SMEM_BYTES - 16); }

DI void phase_compare(const Params& p, unsigned char* smem) {
  const float* a = (const float*)p.out; const float* b = (const float*)(p.ws + OFF_R3);
  float num = 0.f, den = 0.f;
  for (size_t i = (size_t)blockIdx.x * NTHREADS + tidx(); i < (size_t)T * 1024; i += (size_t)gridDim.x * NTHREADS) {
    const int c = (int)(i & 1023);
    if (c >= DBG_LO && c < DBG_HI) { const float d = a[i] - b[i]; num += d * d; den += b[i] * b[i]; }
  }
  num = wave_sum(num); den = wave_sum(den);
  if ((tidx() & 63) == 0) { float* acc = (float*)(p.ws + OFF_MISC) + 24; atomicAdd(acc, num); atomicAdd(acc + 1, den); }
}

#ifndef PROBE_MASK
#define PROBE_MASK 0
#endif
template <int P> DI void run_phase1(const Params& p, unsigned char* smem, int rep) {
  if (P == 0) phase_prep(p, smem);
  else if (P == 1) phase_inproj(p, smem);
  else if (P == 2) { }
  else if (P == 3) { }
  else if (P == 4) {
#if DEBUG_CMP
    phase_attn(p, smem);
    phase_attn_mfma(p, smem, p.out);
#else
    phase_attn_mfma(p, smem, (float*)(p.ws + OFF_R3), rep);
#endif
  }
  else if (P == 5) {
#if DEBUG_CMP
    phase_compare(p, smem);
#endif
    phase_mixnorm(p, smem);
  }
  else if (P == 6) phase_outproj(p, smem);
  else if (P == 7) phase_route(p, smem);
  else if (P == 8) phase_moe(p, smem);
  else if (P == 9) { }
  else phase_final(p, smem);
}
template <int P> DI void run_phase(const Params& p, unsigned char* smem) { run_phase1<P>(p, smem, 0); }

template <int P> __global__ void __launch_bounds__(NTHREADS, 2) phase_kernel(Params p) {
  extern __shared__ __attribute__((aligned(16))) unsigned char smem[];
  run_phase<P>(p, smem);
}

__global__ void __launch_bounds__(NTHREADS, 2) mega_kernel(Params p) {
  extern __shared__ __attribute__((aligned(16))) unsigned char smem[];
  volatile unsigned* st = (volatile unsigned*)(smem + SMEM_BYTES - 16);
  if (tidx() == 0) { st[0] = 0u; st[1] = 0u; }
  __syncthreads();
  const XcdBarrier bar = xcd_barrier_post((unsigned*)(p.ws + OFF_BAR), st);
#define GSYNC() xcd_barrier(bar)
  run_phase<0>(p, smem);
  if (tidx() == 0) st[2] = bar.rank;
  GSYNC(); if ((PROBE_MASK >> 0) & 1) { run_phase1<0>(p, smem, 1); GSYNC(); }
  run_phase<1>(p, smem); GSYNC(); if ((PROBE_MASK >> 1) & 1) { run_phase1<1>(p, smem, 1); GSYNC(); }
  run_phase<4>(p, smem); GSYNC(); if ((PROBE_MASK >> 4) & 1) { run_phase1<4>(p, smem, 1); GSYNC(); }
  run_phase<6>(p, smem); GSYNC(); if ((PROBE_MASK >> 6) & 1) { run_phase1<6>(p, smem, 1); GSYNC(); }
  run_phase<7>(p, smem); GSYNC(); if ((PROBE_MASK >> 7) & 1) { run_phase1<7>(p, smem, 1); GSYNC(); }
  run_phase<8>(p, smem); GSYNC(); if ((PROBE_MASK >> 8) & 1) { run_phase1<8>(p, smem, 1); GSYNC(); }
  run_phase<10>(p, smem);
}

extern "C" void kernel_launch(void* const* d_in, const int* in_sizes, int n_in, void* d_out, int out_size, void* d_ws, size_t ws_size,
                              hipStream_t stream) {
  if (n_in != 22 || ws_size < WS_END) { fprintf(stderr, "kernel_launch: unexpected inputs (n_in %d, ws %zu < %zu)\n", n_in, ws_size, (size_t)WS_END); return; }
  Params p{};
  const float** pf = (const float**)&p;
  for (int i = 0; i < 22; ++i) pf[i] = (const float*)d_in[i];
  p.out = (float*)d_out; p.ws = (unsigned char*)d_ws;
  for (int i = 0; i < 8; ++i) p.inv_freq[i] = (float)pow(500000.0, -(double)i / 8.0);
#if SINGLE
  static int grid_blocks = 0;
  if (!grid_blocks) {
    int dev = 0, cus = 0, per_cu = 0;
    hipGetDevice(&dev);
    hipDeviceGetAttribute(&cus, hipDeviceAttributeMultiprocessorCount, dev);
    hipFuncSetAttribute((const void*)mega_kernel, hipFuncAttributeMaxDynamicSharedMemorySize, SMEM_BYTES);
    hipOccupancyMaxActiveBlocksPerMultiprocessor(&per_cu, mega_kernel, NTHREADS, SMEM_BYTES);
    if (per_cu > 2) per_cu = 2;
    if (per_cu < 1) per_cu = 1;
    grid_blocks = cus * per_cu;
  }
  hipMemsetAsync((unsigned char*)d_ws + OFF_BAR, 0, XCD_BAR_WORDS * 4, stream);
  void* args[] = {&p};
  hipError_t e = hipLaunchCooperativeKernel((void*)mega_kernel, dim3(grid_blocks), dim3(NTHREADS), args, SMEM_BYTES, stream);
  if (e != hipSuccess) fprintf(stderr, "cooperative launch failed: %s (grid %d)\n", hipGetErrorString(e), grid_blocks);
#else
  static int init = 0;
  if (!init) {
    init = 1;
    hipFuncSetAttribute((const void*)phase_kernel<0>, hipFuncAttributeMaxDynamicSharedMemorySize, SMEM_BYTES);
    hipFuncSetAttribute((const void*)phase_kernel<1>, hipFuncAttributeMaxDynamicSharedMemorySize, SMEM_BYTES);
    hipFuncSetAttribute((const void*)phase_kernel<2>, hipFuncAttributeMaxDynamicSharedMemorySize, SMEM_BYTES);
    hipFuncSetAttribute((const void*)phase_kernel<3>, hipFuncAttributeMaxDynamicSharedMemorySize, SMEM_BYTES);
    hipFuncSetAttribute((const void*)phase_kernel<4>, hipFuncAttributeMaxDynamicSharedMemorySize, SMEM_BYTES);
    hipFuncSetAttribute((const void*)phase_kernel<5>, hipFuncAttributeMaxDynamicSharedMemorySize, SMEM_BYTES);
    hipFuncSetAttribute((const void*)phase_kernel<6>, hipFuncAttributeMaxDynamicSharedMemorySize, SMEM_BYTES);
    hipFuncSetAttribute((const void*)phase_kernel<7>, hipFuncAttributeMaxDynamicSharedMemorySize, SMEM_BYTES);
    hipFuncSetAttribute((const void*)phase_kernel<8>, hipFuncAttributeMaxDynamicSharedMemorySize, SMEM_BYTES);
    hipFuncSetAttribute((const void*)phase_kernel<9>, hipFuncAttributeMaxDynamicSharedMemorySize, SMEM_BYTES);
    hipFuncSetAttribute((const void*)phase_kernel<10>, hipFuncAttributeMaxDynamicSharedMemorySize, SMEM_BYTES);
  }
  const int G = 512;
  phase_kernel<0><<<G, NTHREADS, SMEM_BYTES, stream>>>(p);
  phase_kernel<1><<<G, NTHREADS, SMEM_BYTES, stream>>>(p);
  phase_kernel<2><<<G, NTHREADS, SMEM_BYTES, stream>>>(p);
  phase_kernel<3><<<G, NTHREADS, SMEM_BYTES, stream>>>(p);
  phase_kernel<4><<<G, NTHREADS, SMEM_BYTES, stream>>>(p);
  phase_kernel<5><<<G, NTHREADS, SMEM_BYTES, stream>>>(p);
  phase_kernel<6><<<G, NTHREADS, SMEM_BYTES, stream>>>(p);
  phase_kernel<7><<<G, NTHREADS, SMEM_BYTES, stream>>>(p);
  phase_kernel<8><<<G, NTHREADS, SMEM_BYTES, stream>>>(p);
  phase_kernel<9><<<G, NTHREADS, SMEM_BYTES, stream>>>(p);
  phase_kernel<10><<<G, NTHREADS, SMEM_BYTES, stream>>>(p);
#endif
}
```
